# Optimizing an MI355X kernel written in HIP

```python
import math, functools
import jax, jax.numpy as jnp
from jax import lax
import numpy as np

D_MODEL = 1024
BATCH = 2
SEQ = 8192
DEPTH = 1
DEC_BATCH = 128
DEC_SEQ = 1
PAST_LEN = 8192
PAGE_SIZE = 128

WIN_GROUPS = ((128, 1), (512, 4), (2048, 16))
N_GROUPS = 3
A_HEADS = 4
A_HEAD_DIM = D_MODEL // 16
D_A = A_HEADS * A_HEAD_DIM
QBLK = 128
HG_KEY_DIM = 128
HG_VAL_DIM = 128
D_B = D_MODEL // 2
HG_HEADS = D_B // HG_KEY_DIM
HG_CHUNK = 64
MEM_LEN = 256
MEM_HEADS = 4
MEM_HEAD_DIM = D_MODEL // 16
D_M = MEM_HEADS * MEM_HEAD_DIM
N_BRANCH = 3
EPS = 1e-6
IN_SPLITS = (N_GROUPS * D_A, N_GROUPS * D_A, N_GROUPS * D_A, D_A,
             D_B, D_B, D_B, D_B,
             D_M, D_M,
             N_BRANCH * D_MODEL)
D_IN = sum(IN_SPLITS)
F32 = jnp.float32

kernel_name = 'hybrid_dilated_hgrn2_mem_decoder_step'


def _split_points():
    pts, acc = [], 0
    for s in IN_SPLITS[:-1]:
        acc += s
        pts.append(acc)
    return pts


def rms_norm(x, gain):
    x32 = x.astype(F32)
    y = x32 * lax.rsqrt(jnp.mean(x32 * x32, axis=-1, keepdims=True) + EPS)
    return (y * gain.astype(F32)).astype(x.dtype)


def dilated_window_prompt(q, k, v, window, dil):
    B, S, H, Dh = q.shape
    steps = window // dil
    n = S // dil
    nb = -(-n // QBLK)
    pad = nb * QBLK - n

    def blocks(t):
        t = t.astype(F32).reshape(B, n, dil, H, Dh).transpose(0, 2, 1, 3, 4)
        t = jnp.pad(t, ((0, 0), (0, 0), (0, pad), (0, 0), (0, 0)))
        return t.reshape(B, dil, nb, QBLK, H, Dh)

    def with_prev(t):
        prev = jnp.pad(t[:, :, :-1], ((0, 0), (0, 0), (1, 0), (0, 0), (0, 0), (0, 0)))
        return jnp.concatenate([prev, t], axis=3)

    qb = blocks(q)
    kk = with_prev(blocks(k))
    vv = with_prev(blocks(v))
    s = jnp.einsum('brnqhd,brnkhd->brnhqk', qb, kk) * (Dh ** -0.5)
    qi = jnp.arange(QBLK)[:, None]
    kj = jnp.arange(2 * QBLK)[None, :]
    dist = QBLK + qi - kj
    key_idx = (jnp.arange(nb)[:, None, None] - 1) * QBLK + kj[None]
    mask = (dist >= 0) & (dist <= steps) & (key_idx >= 0)
    s = jnp.where(mask[:, None], s, -jnp.inf)
    mx = jnp.max(s, axis=-1, keepdims=True)
    p = jnp.exp(s - mx)
    l = jnp.sum(p, axis=-1, keepdims=True)
    o = jnp.einsum('brnhqk,brnkhd->brnqhd', p, vv)
    o = o / jnp.moveaxis(l[..., 0], 3, 4)[..., None]
    lse = jnp.moveaxis((mx + jnp.log(l))[..., 0], 3, 4)

    def unblock(t):
        t = t.reshape((B, dil, nb * QBLK) + t.shape[4:])[:, :, :n]
        t = jnp.moveaxis(t, 1, 2)
        return t.reshape((B, S) + t.shape[3:])

    return unblock(o), unblock(lse)


def dilated_window_step(q, k, v, kv_buf, window, dil):
    T = q.shape[1]
    L = kv_buf.shape[1]
    Dh = q.shape[-1]
    steps = window // dil
    kc = jnp.concatenate([kv_buf[:, :, 0].astype(F32), k.astype(F32)], axis=1)
    vc = jnp.concatenate([kv_buf[:, :, 1].astype(F32), v.astype(F32)], axis=1)
    idx = L + jnp.arange(T)[:, None] - dil * jnp.arange(steps + 1)[None, :]
    valid = idx >= 0
    idx = jnp.maximum(idx, 0)
    kg = kc[:, idx]
    vg = vc[:, idx]
    s = jnp.einsum('bthd,btmhd->bthm', q.astype(F32), kg) * (Dh ** -0.5)
    s = jnp.where(valid[None, :, None, :], s, -jnp.inf)
    mx = jnp.max(s, axis=-1, keepdims=True)
    p = jnp.exp(s - mx)
    l = jnp.sum(p, axis=-1, keepdims=True)
    o = jnp.einsum('bthm,btmhd->bthd', p, vg) / l
    lse = (mx + jnp.log(l))[..., 0]
    return o, lse


def combine_groups(outs, lses):
    w = jax.nn.softmax(jnp.stack(lses, axis=0), axis=0)
    return jnp.sum(w[..., None] * jnp.stack(outs, axis=0), axis=0)


def window_mixer_prompt(qa, ka, va):
    S = qa.shape[1]
    outs, lses, rows = [], [], []
    for g, (w, d) in enumerate(WIN_GROUPS):
        o, lse = dilated_window_prompt(qa[:, :, g], ka[:, :, g], va[:, :, g], w, d)
        outs.append(o)
        lses.append(lse)
        L = min(w, S)
        rows.append(jnp.stack([ka[:, S - L:, g], va[:, S - L:, g]], axis=2))
    return combine_groups(outs, lses), rows


def window_mixer_step(qa, ka, va, bufs):
    outs, lses, rows = [], [], []
    for g, (w, d) in enumerate(WIN_GROUPS):
        o, lse = dilated_window_step(qa[:, :, g], ka[:, :, g], va[:, :, g], bufs[g], w, d)
        outs.append(o)
        lses.append(lse)
        rows.append(jnp.stack([ka[:, :, g], va[:, :, g]], axis=2))
    return combine_groups(outs, lses), rows


def hgrn2_chunked(q, k, v, g, s0):
    B, L, H, Dk = q.shape
    Dv = v.shape[-1]
    C = min(HG_CHUNK, L)
    nc = -(-L // C)
    pad = nc * C - L

    def chunks(t):
        t = jnp.pad(t.astype(F32), ((0, 0), (0, pad), (0, 0), (0, 0)))
        return t.reshape(B, nc, C, H, t.shape[-1]).transpose(1, 0, 3, 2, 4)

    causal = jnp.tril(jnp.ones((C, C), dtype=bool))[..., None]

    def step(s, inp):
        qc, kc, vc, gc = inp
        G = jnp.cumsum(gc, axis=2)
        o = jnp.einsum('bhtd,bhde->bhte', qc * jnp.exp(G), s)
        diff = G[:, :, :, None, :] - G[:, :, None, :, :]
        decay = jnp.where(causal, jnp.exp(jnp.where(causal, diff, 0.0)), 0.0)
        att = jnp.einsum('bhtsd,bhsd->bhts', qc[:, :, :, None, :] * decay, kc)
        o = o + jnp.einsum('bhts,bhse->bhte', att, vc)
        g_last = G[:, :, -1:, :]
        s = jnp.exp(g_last[:, :, 0, :, None]) * s + jnp.einsum('bhsd,bhse->bhde', kc * jnp.exp(g_last - G), vc)
        return s, o

    s_fin, o = lax.scan(step, s0.astype(F32), (chunks(q), chunks(k), chunks(v), chunks(g)))
    o = o.transpose(1, 0, 3, 2, 4).reshape(B, nc * C, H, Dv)[:, :L]
    return o, s_fin


def memory_kv(mem, gain, w_kv):
    B = mem.shape[0]
    hm = rms_norm(mem, gain)
    return jnp.einsum('bmd,de->bme', hm, w_kv).reshape(B, MEM_LEN, 2, MEM_HEADS, MEM_HEAD_DIM)


def memory_attention(q, mem_kv):
    s = jnp.einsum('bthd,bmhd->bhtm', q.astype(F32), mem_kv[:, :, 0].astype(F32)) * (MEM_HEAD_DIM ** -0.5)
    p = jax.nn.softmax(s, axis=-1)
    return jnp.einsum('bhtm,bmhd->bthd', p, mem_kv[:, :, 1].astype(F32))


def layer_forward(x, win_fn, hg_state0, mem_kv, lb, norm_in_l, w_in_l, norm_hgrn_l,
                  w_branch_a_l, w_branch_b_l, w_branch_m_l, w_out_l):
    B, T, _ = x.shape
    h = rms_norm(x, norm_in_l)
    z = jnp.einsum('btd,de->bte', h, w_in_l)
    qa, ka, va, ga, qb, fb, ib, gb, qm, gm, zg = jnp.split(z, _split_points(), axis=-1)
    grp = lambda t: t.reshape(B, T, N_GROUPS, A_HEADS, A_HEAD_DIM)
    oa, win_rows = win_fn(grp(qa), grp(ka), grp(va))
    ua = oa.reshape(B, T, D_A) * jax.nn.silu(ga.astype(F32))
    f = lb + (1.0 - lb) * jax.nn.sigmoid(fb.astype(F32))
    f = f.reshape(B, T, HG_HEADS, HG_KEY_DIM)
    hq = jax.nn.silu(qb.astype(F32)).reshape(B, T, HG_HEADS, HG_KEY_DIM)
    ob, hg_state = hgrn2_chunked(hq, 1.0 - f, ib.reshape(B, T, HG_HEADS, HG_VAL_DIM), jnp.log(f), hg_state0)
    ub = rms_norm(ob, norm_hgrn_l.reshape(HG_HEADS, HG_VAL_DIM)).reshape(B, T, D_B) * jax.nn.silu(gb.astype(F32))
    om = memory_attention(qm.reshape(B, T, MEM_HEADS, MEM_HEAD_DIM), mem_kv)
    um = om.reshape(B, T, D_M) * jax.nn.silu(gm.astype(F32))
    gates = jax.nn.sigmoid(zg.astype(F32)).reshape(B, T, N_BRANCH, D_MODEL)
    merged = (gates[:, :, 0] * jnp.einsum('btc,cd->btd', ua, w_branch_a_l)
              + gates[:, :, 1] * jnp.einsum('btc,cd->btd', ub, w_branch_b_l)
              + gates[:, :, 2] * jnp.einsum('btc,cd->btd', um, w_branch_m_l))
    x = x + jnp.einsum('btd,de->bte', merged, w_out_l).astype(x.dtype)
    return x, win_rows, hg_state


def setup_inputs(seed: int = 0) -> dict:
    key = jax.random.key(seed)
    ks = jax.random.split(key, 20)

    def nrm(k, shape, scale=1.0):
        return jax.random.normal(k, shape, F32) * scale

    def gain(k, shape):
        return 1.0 + 0.02 * jax.random.normal(k, shape, F32)

    win_len = [min(w, PAST_LEN) for w, _ in WIN_GROUPS]
    kv_tail = (2, A_HEADS, A_HEAD_DIM)
    return {
        'x_prompt': nrm(ks[0], (BATCH, SEQ, D_MODEL)),
        'x_sample': nrm(ks[1], (DEC_BATCH, DEC_SEQ, D_MODEL)),
        'mem_prompt': nrm(ks[2], (BATCH, MEM_LEN, D_MODEL)),
        'cache_w1_kv': nrm(ks[3], (DEPTH, DEC_BATCH, win_len[0]) + kv_tail),
        'cache_w2_kv': nrm(ks[4], (DEPTH, DEC_BATCH, win_len[1]) + kv_tail),
        'cache_w3_kv': nrm(ks[5], (DEPTH, DEC_BATCH, win_len[2]) + kv_tail),
        'cache_mem_kv': nrm(ks[6], (DEPTH, DEC_BATCH, MEM_LEN, 2, MEM_HEADS, MEM_HEAD_DIM)),
        'state_hgrn': nrm(ks[7], (DEPTH, DEC_BATCH, HG_HEADS, HG_KEY_DIM, HG_VAL_DIM), 0.5),
        'norm_in': gain(ks[8], (DEPTH, D_MODEL)),
        'w_in': nrm(ks[9], (DEPTH, D_MODEL, D_IN), D_MODEL ** -0.5),
        'lb_logits': nrm(ks[10], (DEPTH + 1, D_B), 0.5),
        'norm_hgrn': gain(ks[11], (DEPTH, D_B)),
        'norm_mem': gain(ks[12], (DEPTH, D_MODEL)),
        'w_mem_kv': nrm(ks[13], (DEPTH, D_MODEL, 2 * D_M), D_MODEL ** -0.5),
        'w_branch_a': nrm(ks[14], (DEPTH, D_A, D_MODEL), D_A ** -0.5),
        'w_branch_b': nrm(ks[15], (DEPTH, D_B, D_MODEL), D_B ** -0.5),
        'w_branch_m': nrm(ks[16], (DEPTH, D_M, D_MODEL), D_M ** -0.5),
        'w_out': nrm(ks[17], (DEPTH, D_MODEL, D_MODEL), D_MODEL ** -0.5),
        'norm_final': gain(ks[18], (D_MODEL,)),
    }


def reference(x_prompt, x_sample, mem_prompt, cache_w1_kv, cache_w2_kv, cache_w3_kv, cache_mem_kv,
              state_hgrn, norm_in, w_in, lb_logits, norm_hgrn, norm_mem, w_mem_kv, w_branch_a,
              w_branch_b, w_branch_m, w_out, norm_final):
    lb_all = jnp.cumsum(jax.nn.softmax(lb_logits.astype(F32), axis=0), axis=0)
    xp, xs = x_prompt, x_sample
    pw1, pw2, pw3, pmem, phg = [], [], [], [], []
    sw1, sw2, sw3, shg = [], [], [], []
    for l in range(DEPTH):
        mem_kv_p = memory_kv(mem_prompt, norm_mem[l], w_mem_kv[l])
        hg0 = jnp.zeros((xp.shape[0], HG_HEADS, HG_KEY_DIM, HG_VAL_DIM), F32)
        xp, rows_p, hg_p = layer_forward(xp, window_mixer_prompt, hg0, mem_kv_p, lb_all[l],
                                         norm_in[l], w_in[l], norm_hgrn[l], w_branch_a[l],
                                         w_branch_b[l], w_branch_m[l], w_out[l])
        step_fn = functools.partial(window_mixer_step, bufs=(cache_w1_kv[l], cache_w2_kv[l], cache_w3_kv[l]))
        xs, rows_s, hg_s = layer_forward(xs, step_fn, state_hgrn[l], cache_mem_kv[l], lb_all[l],
                                         norm_in[l], w_in[l], norm_hgrn[l], w_branch_a[l],
                                         w_branch_b[l], w_branch_m[l], w_out[l])
        pw1.append(rows_p[0]); pw2.append(rows_p[1]); pw3.append(rows_p[2])
        pmem.append(mem_kv_p); phg.append(hg_p)
        sw1.append(rows_s[0]); sw2.append(rows_s[1]); sw3.append(rows_s[2])
        shg.append(hg_s)
    y_prompt = rms_norm(xp, norm_final)
    y_sample = rms_norm(xs, norm_final)
    return (y_prompt, y_sample, jnp.stack(pw1), jnp.stack(pw2), jnp.stack(pw3), jnp.stack(pmem),
            jnp.stack(phg), jnp.stack(sw1), jnp.stack(sw2), jnp.stack(sw3), jnp.stack(shg))
```

```cpp
#include <hip/hip_runtime.h>
#include <hip/hip_cooperative_groups.h>
#include <cstdio>
namespace cg = cooperative_groups;

#define DI __device__ __forceinline__
typedef unsigned short u16;
typedef float f2v __attribute__((ext_vector_type(2)));
typedef __bf16 b2v __attribute__((ext_vector_type(2)));
typedef short s16x4 __attribute__((ext_vector_type(4)));
typedef unsigned u32x2 __attribute__((ext_vector_type(2)));

DI unsigned pk2(float x, float y) { f2v v = {x, y}; b2v r = __builtin_convertvector(v, b2v); return __builtin_bit_cast(unsigned, r); }
DI u16 f2bf(float x) { __bf16 b = (__bf16)x; return __builtin_bit_cast(u16, b); }
DI float bf2f(u16 v) { return __uint_as_float(((unsigned)v) << 16); }
DI float bflo(unsigned w) { return __uint_as_float(w << 16); }
DI float bfhi(unsigned w) { return __uint_as_float(w & 0xffff0000u); }
DI float sigmoidf_(float x) { return 1.0f / (1.0f + __expf(-x)); }
DI float siluf_(float x) { return x / (1.0f + __expf(-x)); }

constexpr int DM = 1024, SEQ = 8192, NTOK_P = 16384, NTOK_S = 128, NTOK = 16512, MPAD = 16640, DIN = 8192;
constexpr int C_QA = 0, C_KA = 768, C_VA = 1536, C_GA = 2304, C_QB = 2560, C_FB = 3072, C_IB = 3584, C_GB = 4096, C_QM = 4608, C_GM = 4864, C_ZG = 5120;
constexpr float EPSN = 1e-6f;
constexpr size_t O_YP = 0, O_YS = 16777216, O_W1P = 16908288, O_W2P = 17039360, O_W3P = 17563648, O_MKV = 19660800, O_HGP = 19922944,
                 O_W1S = 20054016, O_W2S = 20119552, O_W3S = 20185088, O_HGS = 20250624;
constexpr size_t al256(size_t x) { return (x + 255) & ~(size_t)255; }
constexpr size_t W_H = 0;
constexpr size_t W_HM = W_H + al256((size_t)MPAD * 1024 * 2);
constexpr size_t W_WINT = W_HM + al256((size_t)512 * 1024 * 2);
constexpr size_t W_WMEMT = W_WINT + al256((size_t)8192 * 1024 * 2);
constexpr size_t W_WAT = W_WMEMT + al256((size_t)512 * 1024 * 2);
constexpr size_t W_WBT = W_WAT + al256((size_t)1024 * 256 * 2);
constexpr size_t W_WMT = W_WBT + al256((size_t)1024 * 512 * 2);
constexpr size_t W_WOUTT = W_WMT + al256((size_t)1024 * 256 * 2);
constexpr size_t W_Z = W_WOUTT + al256((size_t)1024 * 1024 * 2);
constexpr size_t W_MEMKV = W_Z + al256((size_t)MPAD * 8192 * 2);
constexpr size_t W_OA = W_MEMKV + al256((size_t)512 * 512 * 2);
constexpr size_t W_LSE = W_OA + al256((size_t)3 * NTOK * 256 * 2);
constexpr size_t W_UA = W_LSE + al256((size_t)3 * NTOK * 4 * 4);
constexpr size_t W_UB = W_UA + al256((size_t)MPAD * 256 * 2);
constexpr size_t W_UM = W_UB + al256((size_t)MPAD * 512 * 2);
constexpr size_t W_SLOC = W_UM + al256((size_t)MPAD * 256 * 2);
constexpr size_t W_ASC = W_SLOC + al256((size_t)256 * 16384 * 4);
constexpr size_t W_SSTART = W_ASC + al256((size_t)256 * 128 * 4);
constexpr size_t W_MACC = W_SSTART + al256((size_t)256 * 16384 * 4);
constexpr size_t W_MERGED = W_MACC + al256((size_t)MPAD * 1024 * 4);
constexpr size_t W_ROWSS = W_MERGED + al256((size_t)MPAD * 1024 * 2);
constexpr size_t W_END = W_ROWSS + al256((size_t)MPAD * 4);

struct Params {
    const float *x_prompt, *x_sample, *mem_prompt, *c_w1, *c_w2, *c_w3, *c_mem, *st_hgrn, *norm_in, *w_in, *lb_logits, *norm_hgrn, *norm_mem,
        *w_mem_kv, *w_a, *w_b, *w_m, *w_out, *norm_final;
    float* out;
    char* ws;
};

namespace pg8 {
#define PG8_LAS __attribute__((address_space(3)))
typedef unsigned short bf16_t;
typedef short bf16x8 __attribute__((ext_vector_type(8)));
typedef float f32x4 __attribute__((ext_vector_type(4)));
typedef unsigned u32x4 __attribute__((ext_vector_type(4)));
constexpr int BM = 256, BK = 64, HALF = 128, HTB = HALF * BK * 2  , STAGE_BYTES = 8 * HTB, NXCD = 8, WGM = 8;

__host__ __device__ __forceinline__ int lds_byte(int r, int c) { const int st = (r >> 4) * 2 + (c >> 5), rr = r & 15, cc = c & 31, ob = rr * 64 + cc * 2; return st * 1024 + (ob ^ (((ob >> 9) & 1) << 5)); }
__host__ __device__ __forceinline__ void stage_rc(int b, int& R, int& C) { const int st = b / 1024, sb = b % 1024, swz = sb ^ (((sb >> 9) & 1) << 5); R = (st >> 1) * 16 + swz / 64; C = (st & 1) * 32 + (swz % 64) / 2; }
__host__ __device__ __forceinline__ int perm32(int rho) { const int n = rho >> 4, i = rho & 15; return 8 * (i >> 2) + 4 * n + (i & 3); }

struct Unit { int pm, pn; };
struct Gemm { const bf16_t* A; const bf16_t* Bt; int M, N, K; };

struct StaticOrder {
    int nM, nN, nwg, G, c;
    __host__ __device__ void init(int M, int N, int G_, int c_) { nM = M / BM; nN = N / BM; nwg = nM * nN; G = G_; c = c_; }
    __host__ __device__ bool next(int i, Unit& u) const {
        const long L = (long)i * G + c; if (L >= nwg) return false;
        int wgid = (int)L; { const int q = nwg / NXCD, r = nwg % NXCD, xcd = wgid % NXCD, off = wgid / NXCD; wgid = (xcd < r ? xcd * (q + 1) : r * (q + 1) + (xcd - r) * q) + off; }
        const int nig = WGM * nN, gid = wgid / nig, fm = gid * WGM, gsz = (nM - fm) < WGM ? (nM - fm) : WGM;
        u.pm = fm + ((wgid % nig) % gsz); u.pn = (wgid % nig) / gsz; return true;
    }
    __device__ __forceinline__ void a_ready(const Unit&) const {}
    __device__ __forceinline__ void done(const Unit&) const {}
};
__device__ __forceinline__ unsigned cvt_pk_bf16(float lo, float hi) { unsigned r; asm volatile("v_cvt_pk_bf16_f32 %0, %1, %2" : "=v"(r) : "v"(lo), "v"(hi)); return r; }
template <class Epi, class Sched, bool STAMP = false>
__device__ __forceinline__ void gemm_phase(PG8_LAS unsigned char* lds, const Gemm g, const Sched& S, const Epi& E, unsigned long long* stamps) {
    const int tid = threadIdx.x, wid = __builtin_amdgcn_readfirstlane(tid >> 6), lane = tid & 63, wr = wid >> 2, wc = wid & 3, fr = lane & 15, fq = lane >> 4;
    const int K = g.K, nt = K / BK;
    int ts_lo = 0, ts_hi = 0, nts = 0; const unsigned long long rt_entry = STAMP ? (unsigned long long)wall_clock64() : 0ull;
#define PG8_STAMP() do { if (STAMP && wid == 0 && nts < 64) { const unsigned long long _c = (unsigned long long)clock64(); \
        ts_lo = (lane == nts) ? (int)(unsigned)_c : ts_lo; ts_hi = (lane == nts) ? (int)(unsigned)(_c >> 32) : ts_hi; ++nts; } } while (0)
    PG8_STAMP();
    unsigned voffA[2], voffB[2];
#pragma unroll
    for (int i = 0; i < 2; ++i) { int R, C; stage_rc(tid * 16 + i * 8192, R, C); const int Rb = Epi::PERM ? ((R & ~31) + perm32(R & 31)) : R;
        voffA[i] = (unsigned)(R * K + C) * 2u; voffB[i] = (unsigned)(Rb * K + C) * 2u; }
    const size_t kstep = (size_t)(BK * 2);
    const size_t hstep = (size_t)HALF * K * 2;
    const size_t tstep = 2 * hstep;
    const unsigned ldsw = (unsigned)wid * 1024u;
    const int aoff = lds_byte(wr * 64 + fr, fq * 8), boff = lds_byte(wc * 32 + fr, fq * 8);
#define PG8_SA(b, h) (((b) * 2 + (h)) * HTB)
#define PG8_SB(b, h) ((4 + (b) * 2 + (h)) * HTB)
#define PG8_STAGE(bufoff, gbase, voff) do { _Pragma("unroll") for (int _i = 0; _i < 2; ++_i) \
        __builtin_amdgcn_global_load_lds((const unsigned*)((const char*)(gbase) + (voff)[_i]), (PG8_LAS unsigned*)(lds + (bufoff) + ldsw + _i * 8192), 16, 0, 0); } while (0)
#define PG8_LDA(dst, b, h) do { _Pragma("unroll") for (int m = 0; m < 4; ++m) _Pragma("unroll") for (int k = 0; k < 2; ++k) dst[m][k] = *(const PG8_LAS bf16x8*)(lds + PG8_SA(b, h) + aoff + m * 2048 + k * 1024); } while (0)
#define PG8_LDB(dst, b, h) do { _Pragma("unroll") for (int n = 0; n < 2; ++n) _Pragma("unroll") for (int k = 0; k < 2; ++k) dst[n][k] = *(const PG8_LAS bf16x8*)(lds + PG8_SB(b, h) + boff + n * 2048 + k * 1024); } while (0)
#define PG8_MMA(ai, bj, At, Bt) do { __builtin_amdgcn_s_setprio(1); _Pragma("unroll") for (int m = 0; m < 4; ++m) _Pragma("unroll") for (int n = 0; n < 2; ++n) _Pragma("unroll") for (int k = 0; k < 2; ++k) \
        acc[ai][bj][m][n] = __builtin_amdgcn_mfma_f32_16x16x32_bf16(Bt[n][k], At[m][k], acc[ai][bj][m][n], 0, 0, 0); __builtin_amdgcn_s_setprio(0); } while (0)
#define PG8_WAIT_V(n) asm volatile("s_waitcnt vmcnt(" #n ")" ::: "memory")
#define PG8_WAIT_L(n) asm volatile("s_waitcnt lgkmcnt(" #n ")" ::: "memory")
#define PG8_BAR __builtin_amdgcn_s_barrier()
#define PG8_SCHED __builtin_amdgcn_sched_barrier(0)
    Unit cur, nxt; int ui = 0;
    if (!S.next(0, cur)) return;
    f32x4 acc[2][2][4][2];
#pragma unroll
    for (int a = 0; a < 2; ++a)
#pragma unroll
        for (int b = 0; b < 2; ++b)
#pragma unroll
            for (int m = 0; m < 4; ++m)
#pragma unroll
                for (int n = 0; n < 2; ++n) acc[a][b][m][n] = (f32x4){0.f, 0.f, 0.f, 0.f};
    bf16x8 At[4][2], B0[2][2], B1[2][2];
    const char* cA = (const char*)g.A + (size_t)cur.pm * tstep; const char* cB = (const char*)g.Bt + (size_t)cur.pn * tstep;
    S.a_ready(cur);
    PG8_STAGE(PG8_SB(0, 0), cB, voffB); PG8_STAGE(PG8_SA(0, 0), cA, voffA); PG8_STAGE(PG8_SB(0, 1), cB + hstep, voffB); PG8_STAGE(PG8_SA(0, 1), cA + hstep, voffA);
    if (wr == 1) PG8_BAR;
    PG8_WAIT_V(4); PG8_BAR;
    PG8_STAGE(PG8_SB(1, 0), cB + kstep, voffB); PG8_STAGE(PG8_SA(1, 0), cA + kstep, voffA); PG8_STAGE(PG8_SB(1, 1), cB + hstep + kstep, voffB);
    PG8_WAIT_V(6); PG8_BAR;
    PG8_STAMP();
    for (;;) {
        const bool has_next = S.next(ui + 1, nxt);
        const char* nA = has_next ? (const char*)g.A + (size_t)nxt.pm * tstep : cA; const char* nB = has_next ? (const char*)g.Bt + (size_t)nxt.pn * tstep : cB;
        for (int t = 0; t < nt; t += 2) {
            const bool last = (t == nt - 2);
            const char* a1 = cA + (size_t)(t + 1) * kstep;
            const char* a2 = last ? nA : cA + (size_t)(t + 2) * kstep; const char* b2 = last ? nB : cB + (size_t)(t + 2) * kstep;
            const char* a3 = a2 + kstep; const char* b3 = b2 + kstep;
            if (last && has_next) S.a_ready(nxt);
            PG8_LDB(B0, 0, 0); PG8_SCHED; PG8_LDA(At, 0, 0); PG8_STAGE(PG8_SA(1, 1), a1 + hstep, voffA);
            PG8_WAIT_L(8); PG8_BAR; PG8_WAIT_L(0); PG8_MMA(0, 0, At, B0); PG8_BAR; PG8_SCHED;
            PG8_LDB(B1, 0, 1); PG8_STAGE(PG8_SB(0, 0), b2, voffB);
            PG8_BAR; PG8_WAIT_L(0); PG8_MMA(0, 1, At, B1); PG8_BAR;
            PG8_LDA(At, 0, 1); PG8_STAGE(PG8_SA(0, 0), a2, voffA);
            PG8_BAR; PG8_WAIT_L(0); PG8_MMA(1, 0, At, B0); PG8_BAR; PG8_SCHED;
            PG8_STAGE(PG8_SB(0, 1), b2 + hstep, voffB);
            PG8_WAIT_V(6); PG8_BAR; PG8_MMA(1, 1, At, B1); PG8_BAR;
            PG8_LDB(B0, 1, 0); PG8_SCHED; PG8_LDA(At, 1, 0); PG8_STAGE(PG8_SA(0, 1), a2 + hstep, voffA);
            PG8_WAIT_L(8); PG8_BAR; PG8_WAIT_L(0); PG8_MMA(0, 0, At, B0); PG8_BAR; PG8_SCHED;
            PG8_LDB(B1, 1, 1); PG8_STAGE(PG8_SB(1, 0), b3, voffB);
            PG8_BAR; PG8_WAIT_L(0); PG8_MMA(0, 1, At, B1); PG8_BAR;
            PG8_LDA(At, 1, 1); PG8_STAGE(PG8_SA(1, 0), a3, voffA);
            PG8_BAR; PG8_WAIT_L(0); PG8_MMA(1, 0, At, B0); PG8_BAR; PG8_SCHED;
            PG8_STAGE(PG8_SB(1, 1), b3 + hstep, voffB);
            PG8_WAIT_V(6); PG8_BAR; PG8_MMA(1, 1, At, B1); PG8_BAR;
        }
        PG8_STAMP();
        if constexpr (!Epi::AFTER_DRAIN) { E(acc, cur, wr, wc, fr, fq); S.done(cur); }
        PG8_STAMP();
        if (!has_next) break;
#pragma unroll
        for (int a = 0; a < 2; ++a)
#pragma unroll
            for (int b = 0; b < 2; ++b)
#pragma unroll
                for (int m = 0; m < 4; ++m)
#pragma unroll
                    for (int n = 0; n < 2; ++n) acc[a][b][m][n] = (f32x4){0.f, 0.f, 0.f, 0.f};
        cur = nxt; cA = nA; cB = nB; ++ui;
    }
    PG8_WAIT_V(0);
    if (wr == 0) PG8_BAR;
    PG8_BAR;
    if constexpr (Epi::AFTER_DRAIN) { E.fused(acc, cur, wr, wc, fr, fq, lds, wid, lane); S.done(cur); }
    PG8_STAMP();
    if (STAMP && wid == 0) { stamps[lane] = lane < nts ? (((unsigned long long)(unsigned)ts_hi << 32) | (unsigned)ts_lo) : 0ull;
        if (lane == 62) stamps[62] = rt_entry; if (lane == 63) stamps[63] = (unsigned long long)wall_clock64(); }
#undef PG8_STAMP
#undef PG8_SA
#undef PG8_SB
#undef PG8_STAGE
#undef PG8_LDA
#undef PG8_LDB
#undef PG8_MMA
#undef PG8_WAIT_V
#undef PG8_WAIT_L
#undef PG8_BAR
#undef PG8_SCHED
}
}

using pg8::bf16x8; using pg8::f32x4; using pg8::u32x4;
#define MFMA16(a, b, c) __builtin_amdgcn_mfma_f32_16x16x32_bf16((a), (b), (c), 0, 0, 0)
DI int otid() { int t = threadIdx.x; asm volatile("" : "+v"(t)); return t; }
DI float wave_sum(float v) { for (int o = 32; o >= 1; o >>= 1) v += __shfl_xor(v, o); return v; }
DI float wave_max(float v) { for (int o = 32; o >= 1; o >>= 1) v = fmaxf(v, __shfl_xor(v, o)); return v; }
DI bf16x8 mk8(unsigned a, unsigned b, unsigned c, unsigned d) { u32x4 w = {a, b, c, d}; return __builtin_bit_cast(bf16x8, w); }
DI bf16x8 pack8(const f32x4& a, const f32x4& b) { return mk8(pk2(a[0], a[1]), pk2(a[2], a[3]), pk2(b[0], b[1]), pk2(b[2], b[3])); }

DI void norm_row(const float* src, const float* gain, u16* dst, int lane) {
    float4 v[4]; float ss = 0.f;
#pragma unroll
    for (int i = 0; i < 4; ++i) { v[i] = ((const float4*)src)[lane + 64 * i]; ss += v[i].x * v[i].x + v[i].y * v[i].y + v[i].z * v[i].z + v[i].w * v[i].w; }
    ss = wave_sum(ss);
    const float rs = rsqrtf(ss * (1.0f / 1024.0f) + EPSN);
#pragma unroll
    for (int i = 0; i < 4; ++i) { const float4 g = ((const float4*)gain)[lane + 64 * i];
        u32x2 w = {pk2(v[i].x * rs * g.x, v[i].y * rs * g.y), pk2(v[i].z * rs * g.z, v[i].w * rs * g.w)};
        *(u32x2*)(dst + (size_t)(lane + 64 * i) * 4) = w; }
}
DI void transpose_tile(const float* src, int K, int N, u16* dst, int tk, int tn, float* t) {
    const int tid = otid();
    { const int r = tid >> 4, c4 = (tid & 15) * 4;
#pragma unroll
      for (int it = 0; it < 2; ++it) { const int k = r + 32 * it; const float4 v = *(const float4*)(src + (size_t)(tk * 64 + k) * N + tn * 64 + c4);
          float* d = t + k * 65 + c4; d[0] = v.x; d[1] = v.y; d[2] = v.z; d[3] = v.w; } }
    __syncthreads();
    { const int n = tid >> 3, ks = (tid & 7) * 8; float a[8];
#pragma unroll
      for (int i = 0; i < 8; ++i) a[i] = t[(ks + i) * 65 + n];
      u32x4 w = {pk2(a[0], a[1]), pk2(a[2], a[3]), pk2(a[4], a[5]), pk2(a[6], a[7])};
      *(u32x4*)(dst + (size_t)(tn * 64 + n) * K + tk * 64 + ks) = w; }
    __syncthreads();
}
DI void phase_prep(const Params& p, char* smem) {
    const int tid = otid(), wid = tid >> 6, lane = tid & 63;
    u16* H = (u16*)(p.ws + W_H); u16* HM = (u16*)(p.ws + W_HM);
    for (int r = blockIdx.x * 8 + wid; r < NTOK + 512; r += gridDim.x * 8) {
        if (r < NTOK_P) norm_row(p.x_prompt + (size_t)r * 1024, p.norm_in, H + (size_t)r * 1024, lane);
        else if (r < NTOK) norm_row(p.x_sample + (size_t)(r - NTOK_P) * 1024, p.norm_in, H + (size_t)r * 1024, lane);
        else norm_row(p.mem_prompt + (size_t)(r - NTOK) * 1024, p.norm_mem, HM + (size_t)(r - NTOK) * 1024, lane);
    }
    { const size_t g = (size_t)blockIdx.x * 512 + tid, gs = (size_t)gridDim.x * 512; const uint4 z4 = {0u, 0u, 0u, 0u};
      uint4* hp = (uint4*)(H + (size_t)NTOK * 1024); for (size_t i = g; i < (size_t)128 * 1024 / 8; i += gs) hp[i] = z4;
      uint4* ua = (uint4*)((u16*)(p.ws + W_UA) + (size_t)NTOK * 256); for (size_t i = g; i < (size_t)128 * 256 / 8; i += gs) ua[i] = z4;
      uint4* ub = (uint4*)((u16*)(p.ws + W_UB) + (size_t)NTOK * 512); for (size_t i = g; i < (size_t)128 * 512 / 8; i += gs) ub[i] = z4;
      uint4* um = (uint4*)((u16*)(p.ws + W_UM) + (size_t)NTOK * 256); for (size_t i = g; i < (size_t)128 * 256 / 8; i += gs) um[i] = z4;
      float* rs = (float*)(p.ws + W_ROWSS); for (size_t i = g; i < (size_t)MPAD; i += gs) rs[i] = 0.f; }
    float* t = (float*)smem;
    for (int j = blockIdx.x; j < 2688; j += gridDim.x) {
        if (j < 2048) transpose_tile(p.w_in, 1024, 8192, (u16*)(p.ws + W_WINT), j & 15, j >> 4, t);
        else if (j < 2176) { const int q = j - 2048; transpose_tile(p.w_mem_kv, 1024, 512, (u16*)(p.ws + W_WMEMT), q & 15, q >> 4, t); }
        else if (j < 2240) { const int q = j - 2176; transpose_tile(p.w_a, 256, 1024, (u16*)(p.ws + W_WAT), q & 3, q >> 2, t); }
        else if (j < 2368) { const int q = j - 2240; transpose_tile(p.w_b, 512, 1024, (u16*)(p.ws + W_WBT), q & 7, q >> 3, t); }
        else if (j < 2432) { const int q = j - 2368; transpose_tile(p.w_m, 256, 1024, (u16*)(p.ws + W_WMT), q & 3, q >> 2, t); }
        else { const int q = j - 2432; transpose_tile(p.w_out, 1024, 1024, (u16*)(p.ws + W_WOUTT), q & 15, q >> 4, t); }
    }
}

struct GDesc { const u16* A; const u16* Bt; int K; int mode; };
struct MUnit { int pm, pn, gi; };
struct MSched {
    pg8::StaticOrder so; int nsub, nreg, ex_pm, ex_pn, ex_gi, has_extra;
    DI bool next(int i, MUnit& u) const {
        const int ti = nsub == 3 ? i / 3 : i, gi = nsub == 3 ? i - 3 * ti : 0;
        pg8::Unit t;
        if (so.next(ti, t)) { u.pm = t.pm; u.pn = t.pn; u.gi = gi; return true; }
        if (has_extra && ti == nreg) { u.pm = ex_pm; u.pn = ex_pn; u.gi = ex_gi; return true; }
        return false;
    }
};
DI void epi_all(const Params& p, int mode, const f32x4 (&acc)[2][2][4][2], const MUnit& u, int wr, int wc, int fr, int fq) {
    const int row0 = u.pm * 256 + wr * 64 + fr, col0 = u.pn * 256 + wc * 32 + 8 * fq;
    if (mode == 0) { u16* O = (u16*)(p.ws + W_Z);
#pragma unroll
        for (int ai = 0; ai < 2; ++ai)
#pragma unroll
            for (int m = 0; m < 4; ++m) { u16* rowp = O + (size_t)(row0 + ai * 128 + m * 16) * DIN + col0;
#pragma unroll
                for (int bj = 0; bj < 2; ++bj) *(bf16x8*)(rowp + bj * 128) = pack8(acc[ai][bj][m][0], acc[ai][bj][m][1]); }
    } else if (mode == 1) { u16* O = (u16*)(p.ws + W_MEMKV); float* F = p.out + O_MKV;
#pragma unroll
        for (int ai = 0; ai < 2; ++ai)
#pragma unroll
            for (int m = 0; m < 4; ++m) { const size_t ro = (size_t)(row0 + ai * 128 + m * 16) * 512 + col0;
#pragma unroll
                for (int bj = 0; bj < 2; ++bj) { *(bf16x8*)(O + ro + bj * 128) = pack8(acc[ai][bj][m][0], acc[ai][bj][m][1]);
                    *(f32x4*)(F + ro + bj * 128) = acc[ai][bj][m][0]; *(f32x4*)(F + ro + bj * 128 + 4) = acc[ai][bj][m][1]; } }
    } else if (mode <= 4) { const u16* Z = (const u16*)(p.ws + W_Z); float* macc = (float*)(p.ws + W_MACC); u16* merged = (u16*)(p.ws + W_MERGED); const int gcol = C_ZG + (mode - 2) * 1024;
#pragma unroll
        for (int ai = 0; ai < 2; ++ai)
#pragma unroll
            for (int m = 0; m < 4; ++m) { const int row = row0 + ai * 128 + m * 16;
#pragma unroll
                for (int bj = 0; bj < 2; ++bj) { const int col = col0 + bj * 128;
                    const u32x4 gz = *(const u32x4*)(Z + (size_t)row * 8192 + gcol + col);
                    const f32x4 g0 = {sigmoidf_(bflo(gz[0])), sigmoidf_(bfhi(gz[0])), sigmoidf_(bflo(gz[1])), sigmoidf_(bfhi(gz[1]))};
                    const f32x4 g1 = {sigmoidf_(bflo(gz[2])), sigmoidf_(bfhi(gz[2])), sigmoidf_(bflo(gz[3])), sigmoidf_(bfhi(gz[3]))};
                    f32x4 r0 = acc[ai][bj][m][0] * g0, r1 = acc[ai][bj][m][1] * g1;
                    float* mp = macc + (size_t)row * 1024 + col;
                    if (mode >= 3) { r0 += *(const f32x4*)mp; r1 += *(const f32x4*)(mp + 4); }
                    if (mode <= 3) { *(f32x4*)mp = r0; *(f32x4*)(mp + 4) = r1; }
                    else *(bf16x8*)(merged + (size_t)row * 1024 + col) = pack8(r0, r1); }
                asm volatile("" ::: "memory"); }
    } else { float* rowss = (float*)(p.ws + W_ROWSS);
#pragma unroll
        for (int ai = 0; ai < 2; ++ai)
#pragma unroll
            for (int m = 0; m < 4; ++m) { const int row = row0 + ai * 128 + m * 16; const bool ok = row < NTOK; float ss = 0.f;
                if (ok) { const float* xr = row < NTOK_P ? p.x_prompt + (size_t)row * 1024 : p.x_sample + (size_t)(row - NTOK_P) * 1024; float* orow = p.out + (size_t)row * 1024;
#pragma unroll
                    for (int bj = 0; bj < 2; ++bj)
#pragma unroll
                        for (int n = 0; n < 2; ++n) { const int col = col0 + bj * 128 + n * 4; const f32x4 r = *(const f32x4*)(xr + col) + acc[ai][bj][m][n];
                            *(f32x4*)(orow + col) = r; ss += r[0] * r[0] + r[1] * r[1] + r[2] * r[2] + r[3] * r[3]; } }
                ss += __shfl_xor(ss, 16); ss += __shfl_xor(ss, 32);
                if (ok && fq == 0) atomicAdd(rowss + row, ss);
                asm volatile("" ::: "memory"); }
    }
}
DI void gemm_multi(PG8_LAS unsigned char* lds, const Params& p, const GDesc d0, const GDesc d1, const GDesc d2, const MSched& S) {
    using namespace pg8;
    const int tid = otid(), wid = __builtin_amdgcn_readfirstlane(tid >> 6), lane = tid & 63, wr = wid >> 2, wc = wid & 3, fr = lane & 15, fq = lane >> 4;
    unsigned ra2[2], rb2[2], c2[2];
#pragma unroll
    for (int i = 0; i < 2; ++i) { int R, C; stage_rc(tid * 16 + i * 8192, R, C); ra2[i] = (unsigned)R * 2u; rb2[i] = (unsigned)((R & ~31) + perm32(R & 31)) * 2u; c2[i] = (unsigned)C * 2u; }
    const size_t kstep = (size_t)(BK * 2);
    const unsigned ldsw = (unsigned)wid * 1024u;
    const int aoff = lds_byte(wr * 64 + fr, fq * 8), boff = lds_byte(wc * 32 + fr, fq * 8);
#define PG8_SA(b, h) (((b) * 2 + (h)) * HTB)
#define PG8_SB(b, h) ((4 + (b) * 2 + (h)) * HTB)
#define PG8_STAGE(bufoff, gbase, voff) do { _Pragma("unroll") for (int _i = 0; _i < 2; ++_i) \
        __builtin_amdgcn_global_load_lds((const unsigned*)((const char*)(gbase) + (voff)[_i]), (PG8_LAS unsigned*)(lds + (bufoff) + ldsw + _i * 8192), 16, 0, 0); } while (0)
#define PG8_LDA(dst, b, h) do { _Pragma("unroll") for (int m = 0; m < 4; ++m) _Pragma("unroll") for (int k = 0; k < 2; ++k) dst[m][k] = *(const PG8_LAS bf16x8*)(lds + PG8_SA(b, h) + aoff + m * 2048 + k * 1024); } while (0)
#define PG8_LDB(dst, b, h) do { _Pragma("unroll") for (int n = 0; n < 2; ++n) _Pragma("unroll") for (int k = 0; k < 2; ++k) dst[n][k] = *(const PG8_LAS bf16x8*)(lds + PG8_SB(b, h) + boff + n * 2048 + k * 1024); } while (0)
#define PG8_MMA(ai, bj, At, Bt) do { __builtin_amdgcn_s_setprio(1); _Pragma("unroll") for (int m = 0; m < 4; ++m) _Pragma("unroll") for (int n = 0; n < 2; ++n) _Pragma("unroll") for (int k = 0; k < 2; ++k) \
        acc[ai][bj][m][n] = __builtin_amdgcn_mfma_f32_16x16x32_bf16(Bt[n][k], At[m][k], acc[ai][bj][m][n], 0, 0, 0); __builtin_amdgcn_s_setprio(0); } while (0)
#define PG8_WAIT_V(n) asm volatile("s_waitcnt vmcnt(" #n ")" ::: "memory")
#define PG8_WAIT_L(n) asm volatile("s_waitcnt lgkmcnt(" #n ")" ::: "memory")
#define PG8_BAR __builtin_amdgcn_s_barrier()
#define PG8_SCHED __builtin_amdgcn_sched_barrier(0)
#define GSEL(gi, f) ((gi) == 0 ? d0.f + 0 : ((gi) == 1 ? d1.f + 0 : d2.f + 0))
    MUnit cur, nxt; int ui = 0;
    if (!S.next(0, cur)) return;
    f32x4 acc[2][2][4][2];
#pragma unroll
    for (int a = 0; a < 2; ++a)
#pragma unroll
        for (int b = 0; b < 2; ++b)
#pragma unroll
            for (int m = 0; m < 4; ++m)
#pragma unroll
                for (int n = 0; n < 2; ++n) acc[a][b][m][n] = (f32x4){0.f, 0.f, 0.f, 0.f};
    bf16x8 At[4][2], B0[2][2], B1[2][2];
    int Kc = GSEL(cur.gi, K); int modec = GSEL(cur.gi, mode);
    const char* cA = (const char*)GSEL(cur.gi, A) + (size_t)cur.pm * ((size_t)512 * Kc); const char* cB = (const char*)GSEL(cur.gi, Bt) + (size_t)cur.pn * ((size_t)512 * Kc);
    {
        const size_t hstep = (size_t)HALF * Kc * 2; unsigned vA[2], vB[2];
#pragma unroll
        for (int i = 0; i < 2; ++i) { vA[i] = ra2[i] * (unsigned)Kc + c2[i]; vB[i] = rb2[i] * (unsigned)Kc + c2[i]; }
        PG8_STAGE(PG8_SB(0, 0), cB, vB); PG8_STAGE(PG8_SA(0, 0), cA, vA); PG8_STAGE(PG8_SB(0, 1), cB + hstep, vB); PG8_STAGE(PG8_SA(0, 1), cA + hstep, vA);
        if (wr == 1) PG8_BAR;
        PG8_WAIT_V(4); PG8_BAR;
        PG8_STAGE(PG8_SB(1, 0), cB + kstep, vB); PG8_STAGE(PG8_SA(1, 0), cA + kstep, vA); PG8_STAGE(PG8_SB(1, 1), cB + hstep + kstep, vB);
        PG8_WAIT_V(6); PG8_BAR;
    }
    for (;;) {
        const bool has_next = S.next(ui + 1, nxt);
        const int Kn = has_next ? GSEL(nxt.gi, K) : Kc; const int moden = has_next ? GSEL(nxt.gi, mode) : modec;
        const char* nA = has_next ? (const char*)GSEL(nxt.gi, A) + (size_t)nxt.pm * ((size_t)512 * Kn) : cA; const char* nB = has_next ? (const char*)GSEL(nxt.gi, Bt) + (size_t)nxt.pn * ((size_t)512 * Kn) : cB;
        const int nt = Kc / BK; const size_t hstepc = (size_t)HALF * Kc * 2;
        unsigned vAc[2];
#pragma unroll
        for (int i = 0; i < 2; ++i) vAc[i] = ra2[i] * (unsigned)Kc + c2[i];
        for (int t = 0; t < nt; t += 2) {
            const bool last = (t == nt - 2);
            const int K2 = last ? Kn : Kc; const size_t hstep2 = (size_t)HALF * K2 * 2;
            unsigned vA2[2], vB2[2];
#pragma unroll
            for (int i = 0; i < 2; ++i) { vA2[i] = ra2[i] * (unsigned)K2 + c2[i]; vB2[i] = rb2[i] * (unsigned)K2 + c2[i]; }
            const char* a1 = cA + (size_t)(t + 1) * kstep;
            const char* a2 = last ? nA : cA + (size_t)(t + 2) * kstep; const char* b2 = last ? nB : cB + (size_t)(t + 2) * kstep;
            const char* a3 = a2 + kstep; const char* b3 = b2 + kstep;
            PG8_LDB(B0, 0, 0); PG8_SCHED; PG8_LDA(At, 0, 0); PG8_STAGE(PG8_SA(1, 1), a1 + hstepc, vAc);
            PG8_WAIT_L(8); PG8_BAR; PG8_WAIT_L(0); PG8_MMA(0, 0, At, B0); PG8_BAR; PG8_SCHED;
            PG8_LDB(B1, 0, 1); PG8_STAGE(PG8_SB(0, 0), b2, vB2);
            PG8_BAR; PG8_WAIT_L(0); PG8_MMA(0, 1, At, B1); PG8_BAR;
            PG8_LDA(At, 0, 1); PG8_STAGE(PG8_SA(0, 0), a2, vA2);
            PG8_BAR; PG8_WAIT_L(0); PG8_MMA(1, 0, At, B0); PG8_BAR; PG8_SCHED;
            PG8_STAGE(PG8_SB(0, 1), b2 + hstep2, vB2);
            PG8_WAIT_V(6); PG8_BAR; PG8_MMA(1, 1, At, B1); PG8_BAR;
            PG8_LDB(B0, 1, 0); PG8_SCHED; PG8_LDA(At, 1, 0); PG8_STAGE(PG8_SA(0, 1), a2 + hstep2, vA2);
            PG8_WAIT_L(8); PG8_BAR; PG8_WAIT_L(0); PG8_MMA(0, 0, At, B0); PG8_BAR; PG8_SCHED;
            PG8_LDB(B1, 1, 1); PG8_STAGE(PG8_SB(1, 0), b3, vB2);
            PG8_BAR; PG8_WAIT_L(0); PG8_MMA(0, 1, At, B1); PG8_BAR;
            PG8_LDA(At, 1, 1); PG8_STAGE(PG8_SA(1, 0), a3, vA2);
            PG8_BAR; PG8_WAIT_L(0); PG8_MMA(1, 0, At, B0); PG8_BAR; PG8_SCHED;
            PG8_STAGE(PG8_SB(1, 1), b3 + hstep2, vB2);
            PG8_WAIT_V(6); PG8_BAR; PG8_MMA(1, 1, At, B1); PG8_BAR;
        }
        epi_all(p, modec, acc, cur, wr, wc, fr, fq);
        if (!has_next) break;
#pragma unroll
        for (int a = 0; a < 2; ++a)
#pragma unroll
            for (int b = 0; b < 2; ++b)
#pragma unroll
                for (int m = 0; m < 4; ++m)
#pragma unroll
                    for (int n = 0; n < 2; ++n) acc[a][b][m][n] = (f32x4){0.f, 0.f, 0.f, 0.f};
        cur = nxt; cA = nA; cB = nB; Kc = Kn; modec = moden; ++ui;
    }
    PG8_WAIT_V(0);
    if (wr == 0) PG8_BAR;
    PG8_BAR;
#undef GSEL
#undef PG8_SA
#undef PG8_SB
#undef PG8_STAGE
#undef PG8_LDA
#undef PG8_LDB
#undef PG8_MMA
#undef PG8_WAIT_V
#undef PG8_WAIT_L
#undef PG8_BAR
#undef PG8_SCHED
}

DI void attn_tile(const Params& p, char* smem, bool is_mem, int idx) {
    const u16* Z = (const u16*)(p.ws + W_Z);
    const int tid = otid(), w = tid >> 6, lane = tid & 63, l15 = lane & 15, g4 = lane >> 4;
    u16* Ks = (u16*)smem;
    unsigned* VT = (unsigned*)(smem + 36864);
    int b, h, grp = 0, dil = 1, r = 0, nb;
    if (is_mem) { b = idx >> 8; h = (idx >> 6) & 3; nb = idx & 63; }
    else { grp = idx >> 9; const int rem = idx & 511; b = rem >> 8; h = (rem >> 6) & 3; const int c = rem & 63; dil = grp == 0 ? 1 : (grp == 1 ? 4 : 16);
           const int nbc = 64 / dil; r = c / nbc; nb = c % nbc; }
    const u16* MK = (const u16*)(p.ws + W_MEMKV);
#pragma unroll
    for (int it = 0; it < 4; ++it) { const int c = tid + 512 * it, kr = c >> 3, seg = c & 7; uint4 v = {0u, 0u, 0u, 0u};
        if (is_mem) v = *(const uint4*)(MK + (size_t)(b * 256 + kr) * 512 + h * 64 + seg * 8);
        else { const int uu = (nb - 1) * 128 + kr; if (uu >= 0) v = *(const uint4*)(Z + ((size_t)b * 8192 + (size_t)uu * dil + r) * 8192 + C_KA + grp * 256 + h * 64 + seg * 8); }
        *(uint4*)(Ks + kr * 72 + seg * 8) = v; }
#pragma unroll
    for (int it = 0; it < 2; ++it) { const int un = tid + 512 * it, seg = un & 7, kp = un >> 3; uint4 va = {0u, 0u, 0u, 0u}, vb = {0u, 0u, 0u, 0u};
        if (is_mem) { const u16* s = MK + (size_t)(b * 256 + 2 * kp) * 512 + 256 + h * 64 + seg * 8; va = *(const uint4*)s; vb = *(const uint4*)(s + 512); }
        else { const int uu = (nb - 1) * 128 + 2 * kp; if (uu >= 0) { const u16* s = Z + ((size_t)b * 8192 + (size_t)uu * dil + r) * 8192 + C_VA + grp * 256 + h * 64 + seg * 8;
                   va = *(const uint4*)s; vb = *(const uint4*)(s + (size_t)dil * 8192); } }
        unsigned* d = VT + (seg * 8) * 129 + kp;
        d[0 * 129] = (va.x & 0xffffu) | (vb.x << 16); d[1 * 129] = (va.x >> 16) | (vb.x & 0xffff0000u);
        d[2 * 129] = (va.y & 0xffffu) | (vb.y << 16); d[3 * 129] = (va.y >> 16) | (vb.y & 0xffff0000u);
        d[4 * 129] = (va.z & 0xffffu) | (vb.z << 16); d[5 * 129] = (va.z >> 16) | (vb.z & 0xffff0000u);
        d[6 * 129] = (va.w & 0xffffu) | (vb.w << 16); d[7 * 129] = (va.w >> 16) | (vb.w & 0xffff0000u); }
    const int qi = 16 * w + l15;
    const size_t qrow = is_mem ? ((size_t)b * 8192 + nb * 128 + qi) : ((size_t)b * 8192 + (size_t)(nb * 128 + qi) * dil + r);
    const u16* qp = Z + qrow * 8192 + (is_mem ? C_QM : C_QA + grp * 256) + h * 64 + g4 * 8;
    const bf16x8 qf0 = *(const bf16x8*)qp, qf1 = *(const bf16x8*)(qp + 32);
    __syncthreads();
    f32x4 s[16];
#pragma unroll
    for (int kb = 0; kb < 16; ++kb) { f32x4 a = {0.f, 0.f, 0.f, 0.f};
        const u16* kp_ = Ks + (kb * 16 + l15) * 72 + g4 * 8;
        a = MFMA16(*(const bf16x8*)kp_, qf0, a); a = MFMA16(*(const bf16x8*)(kp_ + 32), qf1, a); s[kb] = a; }
    float mx = -1e30f;
#pragma unroll
    for (int kb = 0; kb < 16; ++kb)
#pragma unroll
        for (int j = 0; j < 4; ++j) { const int kj = kb * 16 + g4 * 4 + j; float v = s[kb][j] * 0.125f;
            const bool ok = is_mem || (kb < 8 ? (kj >= qi && nb > 0) : (kj - 128 <= qi));
            v = ok ? v : -1e30f; s[kb][j] = v; mx = fmaxf(mx, v); }
    mx = fmaxf(mx, __shfl_xor(mx, 16)); mx = fmaxf(mx, __shfl_xor(mx, 32));
    float l = 0.f;
#pragma unroll
    for (int kb = 0; kb < 16; ++kb)
#pragma unroll
        for (int j = 0; j < 4; ++j) { const float e = __expf(s[kb][j] - mx); s[kb][j] = e; l += e; }
    l += __shfl_xor(l, 16); l += __shfl_xor(l, 32);
    f32x4 o[4];
#pragma unroll
    for (int db = 0; db < 4; ++db) o[db] = (f32x4){0.f, 0.f, 0.f, 0.f};
#pragma unroll
    for (int kk = 0; kk < 8; ++kk) { const bf16x8 pf = pack8(s[2 * kk], s[2 * kk + 1]);
#pragma unroll
        for (int db = 0; db < 4; ++db) { const unsigned* vp = VT + (db * 16 + l15) * 129 + 16 * kk + 2 * g4;
            o[db] = MFMA16(mk8(vp[0], vp[1], vp[8], vp[9]), pf, o[db]); } }
    const float inv = 1.0f / l;
    if (is_mem) { u16* UM = (u16*)(p.ws + W_UM);
#pragma unroll
        for (int db = 0; db < 4; ++db) { const int c = h * 64 + db * 16 + 4 * g4; const u32x2 gw = *(const u32x2*)(Z + qrow * 8192 + C_GM + c);
            u32x2 wv = {pk2(o[db][0] * inv * siluf_(bflo(gw[0])), o[db][1] * inv * siluf_(bfhi(gw[0]))), pk2(o[db][2] * inv * siluf_(bflo(gw[1])), o[db][3] * inv * siluf_(bfhi(gw[1])))};
            *(u32x2*)(UM + qrow * 256 + c) = wv; } }
    else { u16* OA = (u16*)(p.ws + W_OA); float* LSE = (float*)(p.ws + W_LSE); const size_t ro = (size_t)grp * NTOK + qrow;
#pragma unroll
        for (int db = 0; db < 4; ++db) { u32x2 wv = {pk2(o[db][0] * inv, o[db][1] * inv), pk2(o[db][2] * inv, o[db][3] * inv)};
            *(u32x2*)(OA + ro * 256 + h * 64 + db * 16 + 4 * g4) = wv; }
        if (g4 == 0) LSE[ro * 4 + h] = mx + __logf(l); }
    __syncthreads();
}

DI void hg_local(const Params& p, char* smem, int item) {
    const u16* Z = (const u16*)(p.ws + W_Z);
    const int tid = otid(), w = tid >> 6, lane = tid & 63, l15 = lane & 15, g4 = lane >> 4;
    const int bh = item >> 5, sc = item & 31, b = bh >> 2, h = bh & 3;
    const size_t row0 = (size_t)b * 8192 + sc * 256;
    u16* KT = (u16*)smem;
    u16* VT = (u16*)(smem + 34816);
    float* segprod = (float*)(smem + 69632);
    float* carry = segprod + 512;
    const int dk = tid & 127, seg = tid >> 7;
    const float lb = 1.0f / (1.0f + __expf(p.lb_logits[512 + h * 128 + dk] - p.lb_logits[h * 128 + dk]));
    if (tid < 128) carry[tid] = 1.0f;
    f32x4 S[8];
#pragma unroll
    for (int i = 0; i < 8; ++i) S[i] = (f32x4){0.f, 0.f, 0.f, 0.f};
    for (int c = 1; c >= 0; --c) {
        const size_t rbase = row0 + c * 128 + seg * 32;
        float f[32]; float prod = 1.0f;
#pragma unroll
        for (int i = 0; i < 32; ++i) { const float fb = bf2f(Z[(rbase + i) * 8192 + C_FB + h * 128 + dk]); f[i] = lb + (1.0f - lb) * sigmoidf_(fb); prod *= f[i]; }
        segprod[seg * 128 + dk] = prod;
#pragma unroll
        for (int i8 = 0; i8 < 4; ++i8) { unsigned wv[4];
#pragma unroll
            for (int j = 0; j < 4; ++j) { const unsigned lo = Z[(rbase + i8 * 8 + 2 * j) * 8192 + C_IB + h * 128 + dk], hi = Z[(rbase + i8 * 8 + 2 * j + 1) * 8192 + C_IB + h * 128 + dk]; wv[j] = lo | (hi << 16); }
            *(u32x4*)(VT + dk * 136 + seg * 32 + i8 * 8) = (u32x4){wv[0], wv[1], wv[2], wv[3]}; }
        __syncthreads();
        float run = carry[dk];
        for (int s2 = seg + 1; s2 < 4; ++s2) run *= segprod[s2 * 128 + dk];
#pragma unroll
        for (int i8 = 3; i8 >= 0; --i8) { float kt[8];
#pragma unroll
            for (int j = 7; j >= 0; --j) { const int i = i8 * 8 + j; kt[j] = (1.0f - f[i]) * run; run *= f[i]; }
            *(u32x4*)(KT + dk * 136 + seg * 32 + i8 * 8) = (u32x4){pk2(kt[0], kt[1]), pk2(kt[2], kt[3]), pk2(kt[4], kt[5]), pk2(kt[6], kt[7])}; }
        __syncthreads();
#pragma unroll
        for (int ks = 0; ks < 4; ++ks) { const bf16x8 bv = *(const bf16x8*)(VT + (16 * w + l15) * 136 + ks * 32 + g4 * 8);
#pragma unroll
            for (int blk = 0; blk < 8; ++blk) S[blk] = MFMA16(*(const bf16x8*)(KT + (16 * blk + l15) * 136 + ks * 32 + g4 * 8), bv, S[blk]); }
        __syncthreads();
        if (tid < 128) carry[tid] = carry[tid] * segprod[tid] * segprod[128 + tid] * segprod[256 + tid] * segprod[384 + tid];
        __syncthreads();
    }
    float* ASC = (float*)(p.ws + W_ASC); float* SLOC = (float*)(p.ws + W_SLOC) + (size_t)item * 16384;
    if (tid < 128) ASC[item * 128 + tid] = carry[tid];
#pragma unroll
    for (int blk = 0; blk < 8; ++blk)
#pragma unroll
        for (int j = 0; j < 4; ++j) SLOC[(16 * blk + 4 * g4 + j) * 128 + 16 * w + l15] = S[blk][j];
    __syncthreads();
}

DI void hg_out(const Params& p, char* smem, int item) {
    const u16* Z = (const u16*)(p.ws + W_Z);
    const int tid = otid(), w = tid >> 6, lane = tid & 63, l15 = lane & 15, g4 = lane >> 4;
    const int bh = item >> 5, sc = item & 31, b = bh >> 2, h = bh & 3;
    const size_t row0 = (size_t)b * 8192 + sc * 256;
    u16* QT = (u16*)smem;
    u16* KH = (u16*)(smem + 8704);
    u16* KT = (u16*)(smem + 17408);
    u16* VT = (u16*)(smem + 27648);
    float* plast = (float*)(smem + 37888);
    float* tqp = plast + 128;
    float* part = tqp + 512;
    const int dk = tid & 127, tq = tid >> 7;
    const float lb = 1.0f / (1.0f + __expf(p.lb_logits[512 + h * 128 + dk] - p.lb_logits[h * 128 + dk]));
    f32x4 S[8];
    { const float* ss = (const float*)(p.ws + W_SSTART) + (size_t)item * 16384;
#pragma unroll
      for (int blk = 0; blk < 8; ++blk)
#pragma unroll
          for (int j = 0; j < 4; ++j) S[blk][j] = ss[(16 * blk + 4 * g4 + j) * 128 + 16 * w + l15]; }
    const f32x4 gain = *(const f32x4*)(p.norm_hgrn + h * 128 + 16 * w + 4 * g4);
    u16* UB = (u16*)(p.ws + W_UB);
    for (int ch = 0; ch < 8; ++ch) {
        const size_t rbase = row0 + ch * 32 + tq * 8;
        float f[8], P[8], qv[8]; float prod = 1.0f;
#pragma unroll
        for (int j = 0; j < 8; ++j) { const u16* zr = Z + (rbase + j) * 8192 + h * 128 + dk; const float fb = bf2f(zr[C_FB]); f[j] = lb + (1.0f - lb) * sigmoidf_(fb);
            prod *= f[j]; P[j] = prod; qv[j] = siluf_(bf2f(zr[C_QB])); }
        tqp[tq * 128 + dk] = prod;
        { unsigned wv[4];
#pragma unroll
          for (int j = 0; j < 4; ++j) { const unsigned lo = Z[(rbase + 2 * j) * 8192 + C_IB + h * 128 + dk], hi = Z[(rbase + 2 * j + 1) * 8192 + C_IB + h * 128 + dk]; wv[j] = lo | (hi << 16); }
          *(u32x4*)(VT + dk * 40 + tq * 8) = (u32x4){wv[0], wv[1], wv[2], wv[3]}; }
        __syncthreads();
        float pbase = 1.0f;
        for (int t2 = 0; t2 < tq; ++t2) pbase *= tqp[t2 * 128 + dk];
        const float ptot = tqp[dk] * tqp[128 + dk] * tqp[256 + dk] * tqp[384 + dk];
        float kt[8];
#pragma unroll
        for (int j = 0; j < 8; ++j) { const float Pj = pbase * P[j], ipj = 1.0f / Pj, kk = 1.0f - f[j];
            QT[(tq * 8 + j) * 136 + dk] = f2bf(qv[j] * Pj); KH[(tq * 8 + j) * 136 + dk] = f2bf(kk * ipj); kt[j] = kk * ptot * ipj; }
        *(u32x4*)(KT + dk * 40 + tq * 8) = (u32x4){pk2(kt[0], kt[1]), pk2(kt[2], kt[3]), pk2(kt[4], kt[5]), pk2(kt[6], kt[7])};
        if (tq == 0) plast[dk] = ptot;
        __syncthreads();
        f32x4 a00 = {0.f, 0.f, 0.f, 0.f}, a01 = a00, a11 = a00;
#pragma unroll
        for (int ks = 0; ks < 4; ++ks) { const int off = ks * 32 + g4 * 8;
            const bf16x8 k0 = *(const bf16x8*)(KH + l15 * 136 + off), k1 = *(const bf16x8*)(KH + (16 + l15) * 136 + off);
            const bf16x8 q0 = *(const bf16x8*)(QT + l15 * 136 + off), q1 = *(const bf16x8*)(QT + (16 + l15) * 136 + off);
            a00 = MFMA16(k0, q0, a00); a01 = MFMA16(k0, q1, a01); a11 = MFMA16(k1, q1, a11); }
#pragma unroll
        for (int j = 0; j < 4; ++j) { const bool ok = (4 * g4 + j) <= l15; a00[j] = ok ? a00[j] : 0.f; a11[j] = ok ? a11[j] : 0.f; }
        f32x4 o0 = {0.f, 0.f, 0.f, 0.f}, o1 = o0;
#pragma unroll
        for (int ks = 0; ks < 4; ++ks) { const bf16x8 sb = pack8(S[2 * ks], S[2 * ks + 1]);
            const u16* q0p = QT + l15 * 136 + ks * 32 + 4 * g4; const u16* q1p = q0p + 16 * 136;
            const u32x2 a = *(const u32x2*)q0p, bq = *(const u32x2*)(q0p + 16), c = *(const u32x2*)q1p, d = *(const u32x2*)(q1p + 16);
            o0 = MFMA16(sb, mk8(a[0], a[1], bq[0], bq[1]), o0); o1 = MFMA16(sb, mk8(c[0], c[1], d[0], d[1]), o1); }
        { const u16* vp = VT + (16 * w + l15) * 40 + 4 * g4; const u32x2 vlo = *(const u32x2*)vp, vhi = *(const u32x2*)(vp + 16);
          const bf16x8 va = mk8(vlo[0], vlo[1], vhi[0], vhi[1]); const f32x4 zz = {0.f, 0.f, 0.f, 0.f};
          o0 = MFMA16(va, pack8(a00, zz), o0); o1 = MFMA16(va, pack8(a01, a11), o1); }
        { const bf16x8 vb = *(const bf16x8*)(VT + (16 * w + l15) * 40 + g4 * 8);
#pragma unroll
          for (int blk = 0; blk < 8; ++blk) { const f32x4 pl = *(const f32x4*)(plast + 16 * blk + 4 * g4);
              S[blk] = MFMA16(*(const bf16x8*)(KT + (16 * blk + l15) * 40 + g4 * 8), vb, S[blk] * pl); } }
        { float q0 = o0[0] * o0[0] + o0[1] * o0[1] + o0[2] * o0[2] + o0[3] * o0[3], q1 = o1[0] * o1[0] + o1[1] * o1[1] + o1[2] * o1[2] + o1[3] * o1[3];
          q0 += __shfl_xor(q0, 16); q0 += __shfl_xor(q0, 32); q1 += __shfl_xor(q1, 16); q1 += __shfl_xor(q1, 32);
          if (g4 == 0) { part[w * 32 + l15] = q0; part[w * 32 + 16 + l15] = q1; } }
        __syncthreads();
#pragma unroll
        for (int tb = 0; tb < 2; ++tb) { const int t = 16 * tb + l15; float tot = 0.f;
#pragma unroll
            for (int ww = 0; ww < 8; ++ww) tot += part[ww * 32 + t];
            const float rs = rsqrtf(tot * (1.0f / 128.0f) + EPSN); const size_t row = row0 + ch * 32 + t; const f32x4 o = tb ? o1 : o0;
            const u32x2 gw = *(const u32x2*)(Z + row * 8192 + C_GB + h * 128 + 16 * w + 4 * g4);
            u32x2 wv = {pk2(o[0] * rs * gain[0] * siluf_(bflo(gw[0])), o[1] * rs * gain[1] * siluf_(bfhi(gw[0]))),
                        pk2(o[2] * rs * gain[2] * siluf_(bflo(gw[1])), o[3] * rs * gain[3] * siluf_(bfhi(gw[1])))};
            *(u32x2*)(UB + row * 512 + h * 128 + 16 * w + 4 * g4) = wv; }
    }
    __syncthreads();
}

DI void dec_attn(const Params& p, char* smem, int item) {
    const u16* Z = (const u16*)(p.ws + W_Z);
    const int b = item >> 2, src = item & 3;
    const int tid = otid(), w = tid >> 6, lane = tid & 63, h = w & 3, half = w >> 2;
    float* sc = (float*)smem;
    float* po = sc + 4 * 264;
    const int nk = src == 3 ? 256 : 128, dil = src == 0 ? 1 : (src == 1 ? 4 : 16), L = src == 0 ? 128 : (src == 1 ? 512 : 2048);
    const float* cw1 = p.c_w1; const float* cw2 = p.c_w2; const float* cw3 = p.c_w3; const float* cwm = p.c_mem;
    const float* cache = src == 0 ? cw1 + 0 : (src == 1 ? cw2 + 0 : (src == 2 ? cw3 + 0 : cwm + 0));
    const size_t brow = (size_t)b * (src == 3 ? 256 : L);
    const u16* zrow = Z + (size_t)(NTOK_P + b) * 8192;
    const int qcol = (src == 3 ? C_QM : C_QA + src * 256) + h * 64;
    const u32x2 qw = *(const u32x2*)(zrow + qcol + (lane & 15) * 4);
    const float q0 = bflo(qw[0]), q1 = bfhi(qw[0]), q2 = bflo(qw[1]), q3 = bfhi(qw[1]);
    const int per = nk / 2, j0 = half * per;
#pragma unroll 4
    for (int it = 0; it < per / 4; ++it) { const int j = j0 + it * 4 + (lane >> 4); const int row = src == 3 ? j : L - dil * (j + 1);
        const float4 kv = *(const float4*)(cache + (brow + row) * 512 + h * 64 + (lane & 15) * 4);
        float d = kv.x * q0 + kv.y * q1 + kv.z * q2 + kv.w * q3;
        d += __shfl_xor(d, 1); d += __shfl_xor(d, 2); d += __shfl_xor(d, 4); d += __shfl_xor(d, 8);
        if ((lane & 15) == 0) sc[h * 264 + j] = d * 0.125f; }
    if (src < 3 && half == 0) { const u32x2 kw = *(const u32x2*)(zrow + C_KA + src * 256 + h * 64 + (lane & 15) * 4);
        float d = bflo(kw[0]) * q0 + bfhi(kw[0]) * q1 + bflo(kw[1]) * q2 + bfhi(kw[1]) * q3;
        d += __shfl_xor(d, 1); d += __shfl_xor(d, 2); d += __shfl_xor(d, 4); d += __shfl_xor(d, 8);
        if (lane == 0) sc[h * 264 + 128] = d * 0.125f; }
    __syncthreads();
    const int ntot = nk + (src < 3 ? 1 : 0);
    float m = -1e30f;
    for (int j = lane; j < ntot; j += 64) m = fmaxf(m, sc[h * 264 + j]);
    m = wave_max(m);
    float l = 0.f;
    for (int j = lane; j < ntot; j += 64) l += __expf(sc[h * 264 + j] - m);
    l = wave_sum(l);
    float acc = 0.f;
#pragma unroll 8
    for (int jj = 0; jj < per; ++jj) { const int j = j0 + jj; const int row = src == 3 ? j : L - dil * (j + 1);
        const float pj = __expf(sc[h * 264 + j] - m); acc += pj * cache[(brow + row) * 512 + 256 + h * 64 + lane]; }
    if (src < 3 && half == 0) acc += __expf(sc[h * 264 + 128] - m) * bf2f(zrow[C_VA + src * 256 + h * 64 + lane]);
    po[(h * 2 + half) * 64 + lane] = acc;
    __syncthreads();
    if (half == 0) { const float o = (po[(h * 2) * 64 + lane] + po[(h * 2 + 1) * 64 + lane]) / l; const size_t tok = NTOK_P + b;
        if (src < 3) { ((u16*)(p.ws + W_OA))[((size_t)src * NTOK + tok) * 256 + h * 64 + lane] = f2bf(o);
            if (lane == 0) ((float*)(p.ws + W_LSE))[((size_t)src * NTOK + tok) * 4 + h] = m + __logf(l); }
        else ((u16*)(p.ws + W_UM))[tok * 256 + h * 64 + lane] = f2bf(o * siluf_(bf2f(zrow[C_GM + h * 64 + lane]))); }
    __syncthreads();
}

DI void hg_step(const Params& p, char* smem, int item) {
    const u16* Z = (const u16*)(p.ws + W_Z);
    const int b = item >> 2, h = item & 3, tid = otid();
    const u16* zrow = Z + (size_t)(NTOK_P + b) * 8192;
    float* sf = (float*)smem; float* sq = sf + 128; float* sv = sq + 128; float* red = sv + 128;
    float* sss = red + 2048;
    if (tid < 128) { const int c = h * 128 + tid; const float lb = 1.0f / (1.0f + __expf(p.lb_logits[512 + c] - p.lb_logits[c]));
        sf[tid] = lb + (1.0f - lb) * sigmoidf_(bf2f(zrow[C_FB + c])); sq[tid] = siluf_(bf2f(zrow[C_QB + c])); }
    else if (tid < 256) sv[tid - 128] = bf2f(zrow[C_IB + h * 128 + tid - 128]);
    __syncthreads();
    const int c4 = (tid & 31) * 4, r0 = tid >> 5;
    const float* S0 = p.st_hgrn + (size_t)item * 16384; float* SO = p.out + O_HGS + (size_t)item * 16384;
    const float4 v4 = *(const float4*)(sv + c4);
    float4 oa = {0.f, 0.f, 0.f, 0.f};
#pragma unroll
    for (int i = 0; i < 8; ++i) { const int dkk = r0 + 16 * i; const float f = sf[dkk], k = 1.0f - f, q = sq[dkk];
        float4 s = *(const float4*)(S0 + dkk * 128 + c4);
        s.x = f * s.x + k * v4.x; s.y = f * s.y + k * v4.y; s.z = f * s.z + k * v4.z; s.w = f * s.w + k * v4.w;
        *(float4*)(SO + dkk * 128 + c4) = s;
        oa.x += s.x * q; oa.y += s.y * q; oa.z += s.z * q; oa.w += s.w * q; }
    *(float4*)(red + r0 * 128 + c4) = oa;
    __syncthreads();
    float o = 0.f;
    if (tid < 128) {
#pragma unroll
        for (int r = 0; r < 16; ++r) o += red[r * 128 + tid];
        const float q = wave_sum(o * o); if ((tid & 63) == 0) sss[tid >> 6] = q; }
    __syncthreads();
    if (tid < 128) { const float rs = rsqrtf((sss[0] + sss[1]) * (1.0f / 128.0f) + EPSN); const int c = h * 128 + tid;
        ((u16*)(p.ws + W_UB))[(size_t)(NTOK_P + b) * 512 + c] = f2bf(o * rs * p.norm_hgrn[c] * siluf_(bf2f(zrow[C_GB + c]))); }
    __syncthreads();
}

DI void copy_rows(const Params& p, int item) {
    const u16* Z = (const u16*)(p.ws + W_Z);
    const int tid = otid();
    for (int i = 0; i < 16; ++i) { size_t q = (size_t)item * 8192 + i * 512 + tid;
        if (q >= 737280) break;
        size_t oo; int g, L = 0; bool samp = false;
        if (q < 32768) { g = 0; L = 128; oo = O_W1P; } else if (q < 163840) { q -= 32768; g = 1; L = 512; oo = O_W2P; } else if (q < 688128) { q -= 163840; g = 2; L = 2048; oo = O_W3P; }
        else { q -= 688128; g = (int)(q >> 14); q &= 16383; samp = true; oo = g == 0 ? O_W1S : (g == 1 ? O_W2S : O_W3S); }
        const size_t e = q * 4; const int hd = (int)(e & 255), kv = (int)((e >> 8) & 1); size_t zr;
        if (samp) zr = NTOK_P + (e >> 9); else { const size_t bj = e >> 9; const int bb = (int)(bj / L), j = (int)(bj % L); zr = (size_t)bb * 8192 + (8192 - L + j); }
        const u32x2 wv = *(const u32x2*)(Z + zr * 8192 + (kv ? C_VA : C_KA) + g * 256 + hd);
        *(f32x4*)(p.out + oo + e) = (f32x4){bflo(wv[0]), bfhi(wv[0]), bflo(wv[1]), bfhi(wv[1])}; }
}

constexpr int P2_HGL = 256, P2_AW = P2_HGL + 1536, P2_AM = P2_AW + 512, P2_DA = P2_AM + 512, P2_HS = P2_DA + 512, P2_CP = P2_HS + 90;
DI void phase_mix(const Params& p, char* smem) {
    for (int it = blockIdx.x; it < P2_CP; it += gridDim.x) {
        if (it < P2_HGL) hg_local(p, smem, it);
        else if (it < P2_AW) attn_tile(p, smem, false, it - P2_HGL);
        else if (it < P2_AM) attn_tile(p, smem, true, it - P2_AW);
        else if (it < P2_DA) dec_attn(p, smem, it - P2_AM);
        else if (it < P2_HS) hg_step(p, smem, it - P2_DA);
        else copy_rows(p, it - P2_HS);
    }
}

DI void phase_prefix(const Params& p) {
    const float* SLOC = (const float*)(p.ws + W_SLOC); const float* ASC = (const float*)(p.ws + W_ASC); float* SST = (float*)(p.ws + W_SSTART);
    const int tid = otid();
    for (int e = blockIdx.x * 512 + tid; e < 131072; e += gridDim.x * 512) { const int bh = e >> 14, idx = e & 16383, dk = idx >> 7; float s = 0.f;
        for (int sc = 0; sc < 32; ++sc) { const int it = bh * 32 + sc; SST[(size_t)it * 16384 + idx] = s; s = ASC[it * 128 + dk] * s + SLOC[(size_t)it * 16384 + idx]; }
        p.out[O_HGP + e] = s; }
}
DI void phase_hgout(const Params& p, char* smem) {
    for (int it = blockIdx.x; it < 256; it += gridDim.x) hg_out(p, smem, it);
    const u16* Z = (const u16*)(p.ws + W_Z); const u16* OA = (const u16*)(p.ws + W_OA); const float* LSE = (const float*)(p.ws + W_LSE); u16* UA = (u16*)(p.ws + W_UA);
    const int tid = otid();
    for (size_t q = (size_t)blockIdx.x * 512 + tid; q < (size_t)NTOK * 32; q += (size_t)gridDim.x * 512) { const size_t tok = q >> 5; const int c8 = (int)(q & 31) * 8, h = c8 >> 6;
        const float l0 = LSE[(0 * (size_t)NTOK + tok) * 4 + h], l1 = LSE[(1 * (size_t)NTOK + tok) * 4 + h], l2 = LSE[(2 * (size_t)NTOK + tok) * 4 + h];
        const float m = fmaxf(l0, fmaxf(l1, l2)); float w0 = __expf(l0 - m), w1 = __expf(l1 - m), w2 = __expf(l2 - m); const float inv = 1.0f / (w0 + w1 + w2); w0 *= inv; w1 *= inv; w2 *= inv;
        const u32x4 a = *(const u32x4*)(OA + (0 * (size_t)NTOK + tok) * 256 + c8), bq = *(const u32x4*)(OA + (1 * (size_t)NTOK + tok) * 256 + c8), c = *(const u32x4*)(OA + (2 * (size_t)NTOK + tok) * 256 + c8);
        const u32x4 gz = *(const u32x4*)(Z + tok * 8192 + C_GA + c8); u32x4 r;
#pragma unroll
        for (int j = 0; j < 4; ++j) { const float lo = (w0 * bflo(a[j]) + w1 * bflo(bq[j]) + w2 * bflo(c[j])) * siluf_(bflo(gz[j])), hi = (w0 * bfhi(a[j]) + w1 * bfhi(bq[j]) + w2 * bfhi(c[j])) * siluf_(bfhi(gz[j])); r[j] = pk2(lo, hi); }
        *(u32x4*)(UA + tok * 256 + c8) = r; }
}
DI void phase_final(const Params& p) {
    const float* rss = (const float*)(p.ws + W_ROWSS);
    const int tid = otid();
    for (size_t q = (size_t)blockIdx.x * 512 + tid; q < (size_t)NTOK * 256; q += (size_t)gridDim.x * 512) { const size_t row = q >> 8; const int c4 = (int)(q & 255) * 4;
        const float rs = rsqrtf(rss[row] * (1.0f / 1024.0f) + EPSN); const float4 g = *(const float4*)(p.norm_final + c4); float4 v = *(float4*)(p.out + row * 1024 + c4);
        v.x *= rs * g.x; v.y *= rs * g.y; v.z *= rs * g.z; v.w *= rs * g.w; *(float4*)(p.out + row * 1024 + c4) = v; }
}

#ifndef PHMASK
#define PHMASK 0xff
#endif
template <bool COOP>
__global__ __launch_bounds__(512, 2) void mega(Params p, int lo, int hi) {
    extern __shared__ __attribute__((aligned(16))) unsigned char shm[];
    char* smem = (char*)shm;
    PG8_LAS unsigned char* lds = (PG8_LAS unsigned char*)shm;
    const int G = (int)gridDim.x, c = (int)blockIdx.x;
    for (int ph = lo; ph < hi; ++ph) {
        if (ph == 1 || ph == 5 || ph == 6) {
            GDesc d0, d1, d2; MSched S; S.nsub = 1; S.has_extra = 0; S.ex_pm = 0; S.ex_pn = 0; S.ex_gi = 0;
            if (ph == 1) { d0 = GDesc{(const u16*)(p.ws + W_H), (const u16*)(p.ws + W_WINT), 1024, 0}; d1 = GDesc{(const u16*)(p.ws + W_HM), (const u16*)(p.ws + W_WMEMT), 1024, 1}; d2 = d1;
                S.so.init(MPAD, DIN, G, c); const int cc = G - 1 - c; if (cc < 4) { S.has_extra = 1; S.ex_pm = cc >> 1; S.ex_pn = cc & 1; S.ex_gi = 1; } }
            else if (ph == 5) { d0 = GDesc{(const u16*)(p.ws + W_UA), (const u16*)(p.ws + W_WAT), 256, 2}; d1 = GDesc{(const u16*)(p.ws + W_UB), (const u16*)(p.ws + W_WBT), 512, 3};
                d2 = GDesc{(const u16*)(p.ws + W_UM), (const u16*)(p.ws + W_WMT), 256, 4}; S.so.init(MPAD, 1024, G, c); S.nsub = 3; }
            else { d0 = GDesc{(const u16*)(p.ws + W_MERGED), (const u16*)(p.ws + W_WOUTT), 1024, 5}; d1 = d0; d2 = d0; S.so.init(MPAD, 1024, G, c); }
            S.nreg = c < S.so.nwg ? (S.so.nwg - c + G - 1) / G : 0;
            if (PHMASK & 2) gemm_multi(lds, p, d0, d1, d2, S);
        }
        else if (ph == 0) { if (PHMASK & 1) phase_prep(p, smem); }
        else if (ph == 2) { if (PHMASK & 4) phase_mix(p, smem); }
        else if (ph == 3) { if (PHMASK & 8) phase_prefix(p); }
        else if (ph == 4) { if (PHMASK & 16) phase_hgout(p, smem); }
        else { if (PHMASK & 128) phase_final(p); }
        if (COOP && ph + 1 < hi) cg::this_grid().sync();
    }
}

#ifndef MULTI_LAUNCH
#define MULTI_LAUNCH 1
#endif
extern "C" void kernel_launch(void* const* d_in, const int* in_sizes, int n_in, void* d_out, int out_size, void* d_ws, size_t ws_size, hipStream_t stream) {
    constexpr size_t kDynLds = 131072;
    static int grid_blocks = 0;
    if (!grid_blocks) {
        int dev = 0, cus = 0, per_cu = 0;
        hipGetDevice(&dev);
        hipDeviceGetAttribute(&cus, hipDeviceAttributeMultiprocessorCount, dev);
        hipFuncSetAttribute((const void*)mega<true>, hipFuncAttributeMaxDynamicSharedMemorySize, (int)kDynLds);
        hipFuncSetAttribute((const void*)mega<false>, hipFuncAttributeMaxDynamicSharedMemorySize, (int)kDynLds);
        hipOccupancyMaxActiveBlocksPerMultiprocessor(&per_cu, mega<true>, 512, kDynLds);
        if (per_cu < 1) per_cu = 1;
        if (per_cu > 1) per_cu = 1;
        grid_blocks = cus * per_cu;
    }
    Params p{};
    const float* const* in = (const float* const*)d_in;
    p.x_prompt = in[0]; p.x_sample = in[1]; p.mem_prompt = in[2]; p.c_w1 = in[3]; p.c_w2 = in[4]; p.c_w3 = in[5]; p.c_mem = in[6]; p.st_hgrn = in[7];
    p.norm_in = in[8]; p.w_in = in[9]; p.lb_logits = in[10]; p.norm_hgrn = in[11]; p.norm_mem = in[12]; p.w_mem_kv = in[13]; p.w_a = in[14]; p.w_b = in[15];
    p.w_m = in[16]; p.w_out = in[17]; p.norm_final = in[18];
    p.out = (float*)d_out; p.ws = (char*)d_ws;
#if MULTI_LAUNCH
    for (int ph = 0; ph < 8; ++ph) hipLaunchKernelGGL((mega<false>), dim3(grid_blocks), dim3(512), kDynLds, stream, p, ph, ph + 1);
#else
    int lo = 0, hi = 8;
    void* args[] = {&p, &lo, &hi};
    hipError_t e = hipLaunchCooperativeKernel((const void*)mega<true>, dim3(grid_blocks), dim3(512), args, kDynLds, stream);
    if (e != hipSuccess) fprintf(stderr, "cooperative launch failed: %s (grid %d)\n", hipGetErrorString(e), grid_blocks);
#endif
}
```

```cpp
#include <hip/hip_runtime.h>
#include <hip/hip_cooperative_groups.h>
#include <cstdio>
namespace cg = cooperative_groups;

#define DI __device__ __forceinline__
typedef unsigned short u16;
typedef float f2v __attribute__((ext_vector_type(2)));
typedef __bf16 b2v __attribute__((ext_vector_type(2)));
typedef short s16x4 __attribute__((ext_vector_type(4)));
typedef unsigned u32x2 __attribute__((ext_vector_type(2)));

DI unsigned pk2(float x, float y) { f2v v = {x, y}; b2v r = __builtin_convertvector(v, b2v); return __builtin_bit_cast(unsigned, r); }
DI u16 f2bf(float x) { __bf16 b = (__bf16)x; return __builtin_bit_cast(u16, b); }
DI float bf2f(u16 v) { return __uint_as_float(((unsigned)v) << 16); }
DI float bflo(unsigned w) { return __uint_as_float(w << 16); }
DI float bfhi(unsigned w) { return __uint_as_float(w & 0xffff0000u); }
DI float sigmoidf_(float x) { return __builtin_amdgcn_rcpf(1.0f + __expf(-x)); }
DI float siluf_(float x) { return x * __builtin_amdgcn_rcpf(1.0f + __expf(-x)); }

constexpr int DM = 1024, SEQ = 8192, NTOK_P = 16384, NTOK_S = 128, NTOK = 16512, MPAD = 16640, DIN = 8192;
constexpr int C_QA = 0, C_KA = 768, C_VA = 1536, C_GA = 2304, C_QB = 2560, C_FB = 3072, C_IB = 3584, C_GB = 4096, C_QM = 4608, C_GM = 4864, C_ZG = 5120;
constexpr float EPSN = 1e-6f;
constexpr size_t O_YP = 0, O_YS = 16777216, O_W1P = 16908288, O_W2P = 17039360, O_W3P = 17563648, O_MKV = 19660800, O_HGP = 19922944,
                 O_W1S = 20054016, O_W2S = 20119552, O_W3S = 20185088, O_HGS = 20250624;
constexpr size_t al256(size_t x) { return (x + 255) & ~(size_t)255; }
constexpr size_t W_H = 0;
constexpr size_t W_HM = W_H + al256((size_t)MPAD * 1024 * 2);
constexpr size_t W_WINT = W_HM + al256((size_t)512 * 1024 * 2);
constexpr size_t W_WMEMT = W_WINT + al256((size_t)8192 * 1024 * 2);
constexpr size_t W_WAT = W_WMEMT + al256((size_t)512 * 1024 * 2);
constexpr size_t W_WBT = W_WAT + al256((size_t)1024 * 1024 * 2);
constexpr size_t W_WMT = W_WBT + al256((size_t)1024 * 512 * 2);
constexpr size_t W_WOUTT = W_WMT + al256((size_t)1024 * 256 * 2);
constexpr size_t W_Z = W_WOUTT + al256((size_t)1024 * 1024 * 2);
constexpr size_t W_MEMKV = W_Z + al256((size_t)MPAD * 8192 * 2);
constexpr size_t W_OA = W_MEMKV + al256((size_t)512 * 512 * 2);
constexpr size_t W_LSE = W_OA + al256((size_t)3 * NTOK * 256 * 2);
constexpr size_t W_UA = W_LSE + al256((size_t)3 * NTOK * 4 * 4);
constexpr size_t W_UB = W_UA + al256((size_t)MPAD * 1024 * 2);
constexpr size_t W_UM = W_UB + al256((size_t)MPAD * 512 * 2);
constexpr size_t W_SLOC = W_UM + al256((size_t)MPAD * 256 * 2);
constexpr size_t W_ASC = W_SLOC + al256((size_t)256 * 16384 * 4);
constexpr size_t W_SSTART = W_ASC + al256((size_t)256 * 128 * 4);
constexpr size_t W_MACC = W_SSTART + al256((size_t)256 * 16384 * 4);
constexpr size_t W_MERGED = W_MACC + al256((size_t)MPAD * 1024 * 4);
constexpr size_t W_ROWSS = W_MERGED + al256((size_t)MPAD * 1024 * 2);
constexpr size_t W_BAR = W_ROWSS + al256((size_t)MPAD * 4);
constexpr size_t W_CNT = W_BAR + 16384;
constexpr size_t BAR_ZERO_BYTES = 16384 + 66 * 256;
constexpr size_t W_GSC = W_BAR + 36864;
constexpr size_t W_END = W_GSC + (size_t)256 * 3 * 131072;

struct Params {
    const float *x_prompt, *x_sample, *mem_prompt, *c_w1, *c_w2, *c_w3, *c_mem, *st_hgrn, *norm_in, *w_in, *lb_logits, *norm_hgrn, *norm_mem,
        *w_mem_kv, *w_a, *w_b, *w_m, *w_out, *norm_final;
    float* out;
    char* ws;
};

namespace pg8 {
#define PG8_LAS __attribute__((address_space(3)))
typedef unsigned short bf16_t;
typedef short bf16x8 __attribute__((ext_vector_type(8)));
typedef float f32x4 __attribute__((ext_vector_type(4)));
typedef unsigned u32x4 __attribute__((ext_vector_type(4)));
constexpr int BM = 256, BK = 64, HALF = 128, HTB = HALF * BK * 2  , STAGE_BYTES = 8 * HTB, NXCD = 8, WGM = 8;

__host__ __device__ __forceinline__ int lds_byte(int r, int c) { const int st = (r >> 4) * 2 + (c >> 5), rr = r & 15, cc = c & 31, ob = rr * 64 + cc * 2; return st * 1024 + (ob ^ (((ob >> 9) & 1) << 5)); }
__host__ __device__ __forceinline__ void stage_rc(int b, int& R, int& C) { const int st = b / 1024, sb = b % 1024, swz = sb ^ (((sb >> 9) & 1) << 5); R = (st >> 1) * 16 + swz / 64; C = (st & 1) * 32 + (swz % 64) / 2; }
__host__ __device__ __forceinline__ int perm32(int rho) { const int n = rho >> 4, i = rho & 15; return 8 * (i >> 2) + 4 * n + (i & 3); }

struct Unit { int pm, pn; };
struct Gemm { const bf16_t* A; const bf16_t* Bt; int M, N, K; };

struct StaticOrder {
    int nM, nN, nwg, G, c;
    __host__ __device__ void init(int M, int N, int G_, int c_) { nM = M / BM; nN = N / BM; nwg = nM * nN; G = G_; c = c_; }
    __host__ __device__ bool next(int i, Unit& u) const {
        const long L = (long)i * G + c; if (L >= nwg) return false;
        int wgid = (int)L; { const int q = nwg / NXCD, r = nwg % NXCD, xcd = wgid % NXCD, off = wgid / NXCD; wgid = (xcd < r ? xcd * (q + 1) : r * (q + 1) + (xcd - r) * q) + off; }
        const int nig = WGM * nN, gid = wgid / nig, fm = gid * WGM, gsz = (nM - fm) < WGM ? (nM - fm) : WGM;
        u.pm = fm + ((wgid % nig) % gsz); u.pn = (wgid % nig) / gsz; return true;
    }
    __device__ __forceinline__ void a_ready(const Unit&) const {}
    __device__ __forceinline__ void done(const Unit&) const {}
};
__device__ __forceinline__ unsigned cvt_pk_bf16(float lo, float hi) { unsigned r; asm volatile("v_cvt_pk_bf16_f32 %0, %1, %2" : "=v"(r) : "v"(lo), "v"(hi)); return r; }
template <class Epi, class Sched, bool STAMP = false>
__device__ __forceinline__ void gemm_phase(PG8_LAS unsigned char* lds, const Gemm g, const Sched& S, const Epi& E, unsigned long long* stamps) {
    const int tid = threadIdx.x, wid = __builtin_amdgcn_readfirstlane(tid >> 6), lane = tid & 63, wr = wid >> 2, wc = wid & 3, fr = lane & 15, fq = lane >> 4;
    const int K = g.K, nt = K / BK;
    int ts_lo = 0, ts_hi = 0, nts = 0; const unsigned long long rt_entry = STAMP ? (unsigned long long)wall_clock64() : 0ull;
#define PG8_STAMP() do { if (STAMP && wid == 0 && nts < 64) { const unsigned long long _c = (unsigned long long)clock64(); \
        ts_lo = (lane == nts) ? (int)(unsigned)_c : ts_lo; ts_hi = (lane == nts) ? (int)(unsigned)(_c >> 32) : ts_hi; ++nts; } } while (0)
    PG8_STAMP();
    unsigned voffA[2], voffB[2];
#pragma unroll
    for (int i = 0; i < 2; ++i) { int R, C; stage_rc(tid * 16 + i * 8192, R, C); const int Rb = Epi::PERM ? ((R & ~31) + perm32(R & 31)) : R;
        voffA[i] = (unsigned)(R * K + C) * 2u; voffB[i] = (unsigned)(Rb * K + C) * 2u; }
    const size_t kstep = (size_t)(BK * 2);
    const size_t hstep = (size_t)HALF * K * 2;
    const size_t tstep = 2 * hstep;
    const unsigned ldsw = (unsigned)wid * 1024u;
    const int aoff = lds_byte(wr * 64 + fr, fq * 8), boff = lds_byte(wc * 32 + fr, fq * 8);
#define PG8_SA(b, h) (((b) * 2 + (h)) * HTB)
#define PG8_SB(b, h) ((4 + (b) * 2 + (h)) * HTB)
#define PG8_STAGE(bufoff, gbase, voff) do { _Pragma("unroll") for (int _i = 0; _i < 2; ++_i) \
        __builtin_amdgcn_global_load_lds((const unsigned*)((const char*)(gbase) + (voff)[_i]), (PG8_LAS unsigned*)(lds + (bufoff) + ldsw + _i * 8192), 16, 0, 0); } while (0)
#define PG8_LDA(dst, b, h) do { _Pragma("unroll") for (int m = 0; m < 4; ++m) _Pragma("unroll") for (int k = 0; k < 2; ++k) dst[m][k] = *(const PG8_LAS bf16x8*)(lds + PG8_SA(b, h) + aoff + m * 2048 + k * 1024); } while (0)
#define PG8_LDB(dst, b, h) do { _Pragma("unroll") for (int n = 0; n < 2; ++n) _Pragma("unroll") for (int k = 0; k < 2; ++k) dst[n][k] = *(const PG8_LAS bf16x8*)(lds + PG8_SB(b, h) + boff + n * 2048 + k * 1024); } while (0)
#define PG8_MMA(ai, bj, At, Bt) do { __builtin_amdgcn_s_setprio(1); _Pragma("unroll") for (int m = 0; m < 4; ++m) _Pragma("unroll") for (int n = 0; n < 2; ++n) _Pragma("unroll") for (int k = 0; k < 2; ++k) \
        acc[ai][bj][m][n] = __builtin_amdgcn_mfma_f32_16x16x32_bf16(Bt[n][k], At[m][k], acc[ai][bj][m][n], 0, 0, 0); __builtin_amdgcn_s_setprio(0); } while (0)
#define PG8_WAIT_V(n) asm volatile("s_waitcnt vmcnt(" #n ")" ::: "memory")
#define PG8_WAIT_L(n) asm volatile("s_waitcnt lgkmcnt(" #n ")" ::: "memory")
#define PG8_BAR __builtin_amdgcn_s_barrier()
#define PG8_SCHED __builtin_amdgcn_sched_barrier(0)
    Unit cur, nxt; int ui = 0;
    if (!S.next(0, cur)) return;
    f32x4 acc[2][2][4][2];
#pragma unroll
    for (int a = 0; a < 2; ++a)
#pragma unroll
        for (int b = 0; b < 2; ++b)
#pragma unroll
            for (int m = 0; m < 4; ++m)
#pragma unroll
                for (int n = 0; n < 2; ++n) acc[a][b][m][n] = (f32x4){0.f, 0.f, 0.f, 0.f};
    bf16x8 At[4][2], B0[2][2], B1[2][2];
    const char* cA = (const char*)g.A + (size_t)cur.pm * tstep; const char* cB = (const char*)g.Bt + (size_t)cur.pn * tstep;
    S.a_ready(cur);
    PG8_STAGE(PG8_SB(0, 0), cB, voffB); PG8_STAGE(PG8_SA(0, 0), cA, voffA); PG8_STAGE(PG8_SB(0, 1), cB + hstep, voffB); PG8_STAGE(PG8_SA(0, 1), cA + hstep, voffA);
    if (wr == 1) PG8_BAR;
    PG8_WAIT_V(4); PG8_BAR;
    PG8_STAGE(PG8_SB(1, 0), cB + kstep, voffB); PG8_STAGE(PG8_SA(1, 0), cA + kstep, voffA); PG8_STAGE(PG8_SB(1, 1), cB + hstep + kstep, voffB);
    PG8_WAIT_V(6); PG8_BAR;
    PG8_STAMP();
    for (;;) {
        const bool has_next = S.next(ui + 1, nxt);
        const char* nA = has_next ? (const char*)g.A + (size_t)nxt.pm * tstep : cA; const char* nB = has_next ? (const char*)g.Bt + (size_t)nxt.pn * tstep : cB;
        for (int t = 0; t < nt; t += 2) {
            const bool last = (t == nt - 2);
            const char* a1 = cA + (size_t)(t + 1) * kstep;
            const char* a2 = last ? nA : cA + (size_t)(t + 2) * kstep; const char* b2 = last ? nB : cB + (size_t)(t + 2) * kstep;
            const char* a3 = a2 + kstep; const char* b3 = b2 + kstep;
            if (last && has_next) S.a_ready(nxt);
            PG8_LDB(B0, 0, 0); PG8_SCHED; PG8_LDA(At, 0, 0); PG8_STAGE(PG8_SA(1, 1), a1 + hstep, voffA);
            PG8_WAIT_L(8); PG8_BAR; PG8_WAIT_L(0); PG8_MMA(0, 0, At, B0); PG8_BAR; PG8_SCHED;
            PG8_LDB(B1, 0, 1); PG8_STAGE(PG8_SB(0, 0), b2, voffB);
            PG8_BAR; PG8_WAIT_L(0); PG8_MMA(0, 1, At, B1); PG8_BAR;
            PG8_LDA(At, 0, 1); PG8_STAGE(PG8_SA(0, 0), a2, voffA);
            PG8_BAR; PG8_WAIT_L(0); PG8_MMA(1, 0, At, B0); PG8_BAR; PG8_SCHED;
            PG8_STAGE(PG8_SB(0, 1), b2 + hstep, voffB);
            PG8_WAIT_V(6); PG8_BAR; PG8_MMA(1, 1, At, B1); PG8_BAR;
            PG8_LDB(B0, 1, 0); PG8_SCHED; PG8_LDA(At, 1, 0); PG8_STAGE(PG8_SA(0, 1), a2 + hstep, voffA);
            PG8_WAIT_L(8); PG8_BAR; PG8_WAIT_L(0); PG8_MMA(0, 0, At, B0); PG8_BAR; PG8_SCHED;
            PG8_LDB(B1, 1, 1); PG8_STAGE(PG8_SB(1, 0), b3, voffB);
            PG8_BAR; PG8_WAIT_L(0); PG8_MMA(0, 1, At, B1); PG8_BAR;
            PG8_LDA(At, 1, 1); PG8_STAGE(PG8_SA(1, 0), a3, voffA);
            PG8_BAR; PG8_WAIT_L(0); PG8_MMA(1, 0, At, B0); PG8_BAR; PG8_SCHED;
            PG8_STAGE(PG8_SB(1, 1), b3 + hstep, voffB);
            PG8_WAIT_V(6); PG8_BAR; PG8_MMA(1, 1, At, B1); PG8_BAR;
        }
        PG8_STAMP();
        if constexpr (!Epi::AFTER_DRAIN) { E(acc, cur, wr, wc, fr, fq); S.done(cur); }
        PG8_STAMP();
        if (!has_next) break;
#pragma unroll
        for (int a = 0; a < 2; ++a)
#pragma unroll
            for (int b = 0; b < 2; ++b)
#pragma unroll
                for (int m = 0; m < 4; ++m)
#pragma unroll
                    for (int n = 0; n < 2; ++n) acc[a][b][m][n] = (f32x4){0.f, 0.f, 0.f, 0.f};
        cur = nxt; cA = nA; cB = nB; ++ui;
    }
    PG8_WAIT_V(0);
    if (wr == 0) PG8_BAR;
    PG8_BAR;
    if constexpr (Epi::AFTER_DRAIN) { E.fused(acc, cur, wr, wc, fr, fq, lds, wid, lane); S.done(cur); }
    PG8_STAMP();
    if (STAMP && wid == 0) { stamps[lane] = lane < nts ? (((unsigned long long)(unsigned)ts_hi << 32) | (unsigned)ts_lo) : 0ull;
        if (lane == 62) stamps[62] = rt_entry; if (lane == 63) stamps[63] = (unsigned long long)wall_clock64(); }
#undef PG8_STAMP
#undef PG8_SA
#undef PG8_SB
#undef PG8_STAGE
#undef PG8_LDA
#undef PG8_LDB
#undef PG8_MMA
#undef PG8_WAIT_V
#undef PG8_WAIT_L
#undef PG8_BAR
#undef PG8_SCHED
}
}
#define XB_TMO      128
#define XB_XCNT(j)  (256  + 64 * (j))
#define XB_XSUB(j)  (1280 + 64 * (j))
#define XB_XGEN(j)  (2304 + 64 * (j))
#define XB_TOP      3328
#define XB_TOPGEN   3392
#define XCD_BAR_WORDS 3456
#define XB_SPIN_CAP (1u << 18)

__device__ __forceinline__ unsigned xb_ld(unsigned* p)              { return __hip_atomic_load(p, __ATOMIC_RELAXED, __HIP_MEMORY_SCOPE_AGENT); }
__device__ __forceinline__ unsigned xb_add(unsigned* p, unsigned v) { return __hip_atomic_fetch_add(p, v, __ATOMIC_RELAXED, __HIP_MEMORY_SCOPE_AGENT); }
__device__ __forceinline__ unsigned xb_xcc_id() { return (unsigned)__builtin_amdgcn_s_getreg((3 << 11) | 20) & 0xFu; }
#define XB_SPIN(cond, bar) do { unsigned _sp = 0; while (cond) { __builtin_amdgcn_s_sleep(1); \
    if ((++_sp & 255u) == 0u) { if (xb_ld(&(bar)[XB_TMO])) break; if (_sp > XB_SPIN_CAP) { atomicAdd(&(bar)[XB_TMO], 1u); break; } } } } while (0)

struct XcdBarrier {
    unsigned* bar; unsigned x;
    volatile PG8_LAS unsigned* st;
};

__device__ __forceinline__ XcdBarrier xcd_barrier_post(unsigned* bar, volatile PG8_LAS unsigned* st) {
    XcdBarrier b; b.bar = bar; b.x = xb_xcc_id(); b.st = st;
    if (threadIdx.x == 0) (void)xb_add(&bar[XB_XCNT(b.x)], 1u);
    return b;
}
__device__ __forceinline__ void xcd_barrier_complete(unsigned* bar, unsigned x, unsigned& nloc, unsigned& nx) {
    const unsigned G = gridDim.x * gridDim.y * gridDim.z;
    unsigned sum, cnt, mine, sp = 0u;
    for (;;) {
        sum = 0u; cnt = 0u; mine = 0u;
#pragma unroll
        for (unsigned j = 0; j < 16; ++j) { const unsigned c = xb_ld(&bar[XB_XCNT(j)]); sum += c; cnt += (c > 0u) ? 1u : 0u; mine = (j == x) ? c : mine; }
        if (sum == G) break;
        __builtin_amdgcn_s_sleep(1);
        if ((++sp & 255u) == 0u) { if (xb_ld(&bar[XB_TMO])) break; if (sp > XB_SPIN_CAP) { atomicAdd(&bar[XB_TMO], 1u); break; } }
    }
    nloc = mine > 0u ? mine : 1u; nx = cnt > 0u ? cnt : 1u;
}

__device__ __forceinline__ void xcd_barrier(const XcdBarrier& b) {
    asm volatile("s_waitcnt vmcnt(0)" ::: "memory");
    __syncthreads();
    if (threadIdx.x == 0) {
        unsigned* bar = b.bar;
        __builtin_amdgcn_s_waitcnt(0);
        unsigned nloc = b.st[0], nx = b.st[1];
        if (nloc == 0u) { xcd_barrier_complete(bar, b.x, nloc, nx); b.st[0] = nloc; b.st[1] = nx; }
        const unsigned old = xb_add(&bar[XB_XSUB(b.x)], 1u);
        const unsigned gen = old / nloc;
        if (old + 1u == (gen + 1u) * nloc) {
            __builtin_amdgcn_fence(__ATOMIC_RELEASE, "agent");
            asm volatile("s_waitcnt vmcnt(0)" ::: "memory");
            const unsigned og = xb_add(&bar[XB_TOP], 1u);
            const unsigned tg = og / nx;
            if (og + 1u == (tg + 1u) * nx) xb_add(&bar[XB_TOPGEN], 1u);
            else XB_SPIN(xb_ld(&bar[XB_TOPGEN]) == tg, bar);
            __builtin_amdgcn_fence(__ATOMIC_ACQUIRE, "agent");
            xb_add(&bar[XB_XGEN(b.x)], 1u);
            asm volatile("s_waitcnt vmcnt(0)" ::: "memory");
        } else {
            XB_SPIN(xb_ld(&bar[XB_XGEN(b.x)]) == gen, bar);
            __builtin_amdgcn_fence(__ATOMIC_ACQUIRE, "agent");
            asm volatile("s_waitcnt vmcnt(0)" ::: "memory");
        }
    }
    __syncthreads();
}

using pg8::bf16x8; using pg8::f32x4; using pg8::u32x4;
#define MFMA16(a, b, c) __builtin_amdgcn_mfma_f32_16x16x32_bf16((a), (b), (c), 0, 0, 0)
DI int otid() { int t = threadIdx.x; asm volatile("" : "+v"(t)); return t; }
DI float wave_sum(float v) { for (int o = 32; o >= 1; o >>= 1) v += __shfl_xor(v, o); return v; }
DI float wave_max(float v) { for (int o = 32; o >= 1; o >>= 1) v = fmaxf(v, __shfl_xor(v, o)); return v; }
DI bf16x8 mk8(unsigned a, unsigned b, unsigned c, unsigned d) { u32x4 w = {a, b, c, d}; return __builtin_bit_cast(bf16x8, w); }
DI bf16x8 pack8(const f32x4& a, const f32x4& b) { return mk8(pk2(a[0], a[1]), pk2(a[2], a[3]), pk2(b[0], b[1]), pk2(b[2], b[3])); }

DI void norm_row(const float* src, const float* gain, u16* dst, int lane) {
    float4 v[4]; float ss = 0.f;
#pragma unroll
    for (int i = 0; i < 4; ++i) { v[i] = ((const float4*)src)[lane + 64 * i]; ss += v[i].x * v[i].x + v[i].y * v[i].y + v[i].z * v[i].z + v[i].w * v[i].w; }
    ss = wave_sum(ss);
    const float rs = rsqrtf(ss * (1.0f / 1024.0f) + EPSN);
#pragma unroll
    for (int i = 0; i < 4; ++i) { const float4 g = ((const float4*)gain)[lane + 64 * i];
        u32x2 w = {pk2(v[i].x * rs * g.x, v[i].y * rs * g.y), pk2(v[i].z * rs * g.z, v[i].w * rs * g.w)};
        *(u32x2*)(dst + (size_t)(lane + 64 * i) * 4) = w; }
}
struct TJob { const float* src; u16* dst; int K, N, tk, tn, ldk, koff; };
DI TJob tjob(const Params& p, int j) {
    TJob t;
    if (j < 2048) t = TJob{p.w_in, (u16*)(p.ws + W_WINT), 1024, 8192, j & 15, j >> 4, 1024, 0};
    else if (j < 2176) { const int q = j - 2048; t = TJob{p.w_mem_kv, (u16*)(p.ws + W_WMEMT), 1024, 512, q & 15, q >> 4, 1024, 0}; }
    else if (j < 2240) { const int q = j - 2176; t = TJob{p.w_a, (u16*)(p.ws + W_WAT), 256, 1024, q & 3, q >> 2, 1024, 0}; }
    else if (j < 2368) { const int q = j - 2240; t = TJob{p.w_b, (u16*)(p.ws + W_WAT), 512, 1024, q & 7, q >> 3, 1024, 256}; }
    else if (j < 2432) { const int q = j - 2368; t = TJob{p.w_m, (u16*)(p.ws + W_WAT), 256, 1024, q & 3, q >> 2, 1024, 768}; }
    else { const int q = j - 2432; t = TJob{p.w_out, (u16*)(p.ws + W_WOUTT), 1024, 1024, q & 15, q >> 4, 1024, 0}; }
    return t;
}
DI void tload(const TJob& t, int tid, float4 (&v)[2]) {
    const int r = tid >> 4, c4 = (tid & 15) * 4;
#pragma unroll
    for (int it = 0; it < 2; ++it) v[it] = *(const float4*)(t.src + (size_t)(t.tk * 64 + r + 32 * it) * t.N + t.tn * 64 + c4);
}
DI void phase_prep(const Params& p, char* smem) {
    const int tid = otid(), wid = tid >> 6, lane = tid & 63;
    u16* H = (u16*)(p.ws + W_H); u16* HM = (u16*)(p.ws + W_HM);
    float* t = (float*)smem;
    { int j = blockIdx.x; const int G = gridDim.x;
      if (j < 2688) { TJob cur = tjob(p, j); float4 v[2]; tload(cur, tid, v);
        for (;;) {
            { const int r = tid >> 4, c4 = (tid & 15) * 4;
#pragma unroll
              for (int it = 0; it < 2; ++it) { float* d = t + (r + 32 * it) * 65 + c4; d[0] = v[it].x; d[1] = v[it].y; d[2] = v[it].z; d[3] = v[it].w; } }
            __syncthreads();
            const int jn = j + G; const bool more = jn < 2688; TJob nx = cur;
            if (more) { nx = tjob(p, jn); tload(nx, tid, v); }
            { const int n = tid >> 3, ks = (tid & 7) * 8; float a[8];
#pragma unroll
              for (int i = 0; i < 8; ++i) a[i] = t[(ks + i) * 65 + n];
              u32x4 w = {pk2(a[0], a[1]), pk2(a[2], a[3]), pk2(a[4], a[5]), pk2(a[6], a[7])};
              *(u32x4*)(cur.dst + (size_t)(cur.tn * 64 + n) * cur.ldk + cur.koff + cur.tk * 64 + ks) = w; }
            __syncthreads();
            if (!more) break;
            j = jn; cur = nx;
        } } }
    { const int nw = gridDim.x * 8;
      for (int r = blockIdx.x * 8 + wid; r < NTOK + 512; r += 2 * nw) {
        const int r2 = r + nw; const bool two = r2 < NTOK + 512;
        const float* s0; const float* g0; u16* d0; const float* s1; const float* g1; u16* d1;
        if (r < NTOK_P) { s0 = p.x_prompt + (size_t)r * 1024; g0 = p.norm_in; d0 = H + (size_t)r * 1024; }
        else if (r < NTOK) { s0 = p.x_sample + (size_t)(r - NTOK_P) * 1024; g0 = p.norm_in; d0 = H + (size_t)r * 1024; }
        else { s0 = p.mem_prompt + (size_t)(r - NTOK) * 1024; g0 = p.norm_mem; d0 = HM + (size_t)(r - NTOK) * 1024; }
        const int rr = two ? r2 : r;
        if (rr < NTOK_P) { s1 = p.x_prompt + (size_t)rr * 1024; g1 = p.norm_in; d1 = H + (size_t)rr * 1024; }
        else if (rr < NTOK) { s1 = p.x_sample + (size_t)(rr - NTOK_P) * 1024; g1 = p.norm_in; d1 = H + (size_t)rr * 1024; }
        else { s1 = p.mem_prompt + (size_t)(rr - NTOK) * 1024; g1 = p.norm_mem; d1 = HM + (size_t)(rr - NTOK) * 1024; }
        float4 va[4], vb[4]; float sa = 0.f, sb = 0.f;
#pragma unroll
        for (int i = 0; i < 4; ++i) { va[i] = ((const float4*)s0)[lane + 64 * i]; vb[i] = ((const float4*)s1)[lane + 64 * i]; }
#pragma unroll
        for (int i = 0; i < 4; ++i) { sa += va[i].x * va[i].x + va[i].y * va[i].y + va[i].z * va[i].z + va[i].w * va[i].w; sb += vb[i].x * vb[i].x + vb[i].y * vb[i].y + vb[i].z * vb[i].z + vb[i].w * vb[i].w; }
        sa = wave_sum(sa); sb = wave_sum(sb);
        const float ra = rsqrtf(sa * (1.0f / 1024.0f) + EPSN), rb = rsqrtf(sb * (1.0f / 1024.0f) + EPSN);
#pragma unroll
        for (int i = 0; i < 4; ++i) { const float4 ga = ((const float4*)g0)[lane + 64 * i], gb = ((const float4*)g1)[lane + 64 * i];
            u32x2 wa = {pk2(va[i].x * ra * ga.x, va[i].y * ra * ga.y), pk2(va[i].z * ra * ga.z, va[i].w * ra * ga.w)};
            u32x2 wb = {pk2(vb[i].x * rb * gb.x, vb[i].y * rb * gb.y), pk2(vb[i].z * rb * gb.z, vb[i].w * rb * gb.w)};
            *(u32x2*)(d0 + (size_t)(lane + 64 * i) * 4) = wa; if (two) *(u32x2*)(d1 + (size_t)(lane + 64 * i) * 4) = wb; }
      } }
    { const size_t g = (size_t)blockIdx.x * 512 + tid, gs = (size_t)gridDim.x * 512;
      float* rs = (float*)(p.ws + W_ROWSS); for (size_t i = g; i < (size_t)MPAD; i += gs) rs[i] = 0.f; }
}

struct GDesc { const u16* A; const u16* Bt; int K; int mode; };
struct MUnit { int pm, pn, gi; };
struct MSched {
    pg8::StaticOrder so; int nsub, nreg, ex_pm, ex_pn, ex_gi, has_extra;
    DI bool next(int i, MUnit& u) const {
        const int ti = nsub == 4 ? (i >> 2) : i, gi = nsub == 4 ? (i & 3) : 0;
        pg8::Unit t;
        if (so.next(ti, t)) { u.pm = t.pm; u.pn = t.pn; u.gi = gi; return true; }
        if (has_extra && ti == nreg) { u.pm = ex_pm; u.pn = ex_pn; u.gi = ex_gi; return true; }
        return false;
    }
};
DI void epi_all(const Params& p, int mode, const f32x4 (&acc)[2][2][4][2], const MUnit& u, size_t rsoff) {
    const int tq_ = otid(), wq_ = tq_ >> 6, wr = wq_ >> 2, wc = wq_ & 3, fr = tq_ & 15, fq = (tq_ >> 4) & 3;
    const int row0 = u.pm * 256 + wr * 64 + fr, col0 = u.pn * 256 + wc * 32 + 8 * fq;
    if (mode == 0) { u16* O = (u16*)(p.ws + W_Z);
#pragma unroll
        for (int ai = 0; ai < 2; ++ai)
#pragma unroll
            for (int m = 0; m < 4; ++m) { u16* rowp = O + (size_t)(row0 + ai * 128 + m * 16) * DIN + col0;
#pragma unroll
                for (int bj = 0; bj < 2; ++bj) *(bf16x8*)(rowp + bj * 128) = pack8(acc[ai][bj][m][0], acc[ai][bj][m][1]);
                asm volatile("" ::: "memory"); }
    } else if (mode == 1) { u16* O = (u16*)(p.ws + W_MEMKV); float* F = p.out + O_MKV;
#pragma unroll
        for (int ai = 0; ai < 2; ++ai)
#pragma unroll
            for (int m = 0; m < 4; ++m) { const size_t ro = (size_t)(row0 + ai * 128 + m * 16) * 512 + col0;
#pragma unroll
                for (int bj = 0; bj < 2; ++bj) { *(bf16x8*)(O + ro + bj * 128) = pack8(acc[ai][bj][m][0], acc[ai][bj][m][1]);
                    *(f32x4*)(F + ro + bj * 128) = acc[ai][bj][m][0]; *(f32x4*)(F + ro + bj * 128 + 4) = acc[ai][bj][m][1]; }
                asm volatile("" ::: "memory"); }
    } else if (mode == 7) {
        u16* G = (u16*)(p.ws + W_GSC) + ((size_t)blockIdx.x * 3 + u.gi) * 65536 + (size_t)(wr * 64 + fr) * 256 + wc * 32 + 8 * fq;
#pragma unroll
        for (int ai = 0; ai < 2; ++ai)
#pragma unroll
            for (int m = 0; m < 4; ++m) {
#pragma unroll
                for (int bj = 0; bj < 2; ++bj) *(bf16x8*)(G + (ai * 128 + m * 16) * 256 + bj * 128) = pack8(acc[ai][bj][m][0], acc[ai][bj][m][1]);
                asm volatile("" ::: "memory"); }
    } else if (mode == 6) {
        const u16* GS = (const u16*)(p.ws + W_GSC) + ((size_t)blockIdx.x * 3 + 2) * 65536 + (size_t)(wr * 64 + fr) * 256 + wc * 32 + 8 * fq; u16* merged = (u16*)(p.ws + W_MERGED);
#pragma unroll
        for (int ai = 0; ai < 2; ++ai) { u32x4 ga[4][2];
#pragma unroll
            for (int m = 0; m < 4; ++m)
#pragma unroll
                for (int bj = 0; bj < 2; ++bj) ga[m][bj] = *(const u32x4*)(GS + (ai * 128 + m * 16) * 256 + bj * 128);
#pragma unroll
            for (int m = 0; m < 4; ++m)
#pragma unroll
                for (int bj = 0; bj < 2; ++bj) { float f[8];
#pragma unroll
                    for (int j = 0; j < 4; ++j) { f[2 * j] = __builtin_amdgcn_rcpf(1.0f + __expf(-bflo(ga[m][bj][j]))); f[2 * j + 1] = __builtin_amdgcn_rcpf(1.0f + __expf(-bfhi(ga[m][bj][j]))); }
                    const f32x4 r0 = acc[ai][bj][m][0] * (f32x4){f[0], f[1], f[2], f[3]}, r1 = acc[ai][bj][m][1] * (f32x4){f[4], f[5], f[6], f[7]};
                    *(bf16x8*)(merged + (size_t)(row0 + ai * 128 + m * 16) * 1024 + col0 + bj * 128) = pack8(r0, r1); }
            asm volatile("" ::: "memory"); }
    } else { float* rowss = (float*)(p.ws + W_ROWSS + rsoff);
#pragma unroll
        for (int pr = 0; pr < 4; ++pr) { f32x4 xv[2][2][2];
#pragma unroll
            for (int q = 0; q < 2; ++q) { const int am = pr * 2 + q, ai = am >> 2, m = am & 3; const int row = row0 + ai * 128 + m * 16;
                const float* xr = row < NTOK_P ? p.x_prompt + (size_t)row * 1024 : p.x_sample + (size_t)(row - NTOK_P) * 1024;
#pragma unroll
                for (int bj = 0; bj < 2; ++bj)
#pragma unroll
                    for (int n = 0; n < 2; ++n) xv[q][bj][n] = *(const f32x4*)(xr + col0 + bj * 128 + n * 4); }
#pragma unroll
            for (int q = 0; q < 2; ++q) { const int am = pr * 2 + q, ai = am >> 2, m = am & 3; const int row = row0 + ai * 128 + m * 16; u16* orow = (u16*)(p.ws + W_MACC) + (size_t)row * 1024; float ss = 0.f;
#pragma unroll
                for (int bj = 0; bj < 2; ++bj)
#pragma unroll
                    for (int n = 0; n < 2; ++n) { const f32x4 r = xv[q][bj][n] + acc[ai][bj][m][n]; u32x2 wv = {pk2(r[0], r[1]), pk2(r[2], r[3])}; *(u32x2*)(orow + col0 + bj * 128 + n * 4) = wv; ss += r[0] * r[0] + r[1] * r[1] + r[2] * r[2] + r[3] * r[3]; }
                ss += __shfl_xor(ss, 16); ss += __shfl_xor(ss, 32);
                if (fq == 0) atomicAdd(rowss + row, ss); }
            asm volatile("" ::: "memory"); }
    }
}
DI void epi_fused(const Params& p, PG8_LAS unsigned char* lds, f32x4 (&acc)[2][2][4][2], const MUnit& u, size_t rsoff) {
    const int tq_ = otid(), wq_ = tq_ >> 6, wr = wq_ >> 2, wc = wq_ & 3, fr = tq_ & 15, fq = (tq_ >> 4) & 3;
    const int row0 = u.pm * 256 + wr * 64 + fr, col0 = u.pn * 256 + wc * 32 + 8 * fq;
    float* rowss = (float*)(p.ws + W_ROWSS + rsoff);
    unsigned* cnt = (unsigned*)(p.ws + W_CNT) + 64 * u.pm;
#pragma unroll
    for (int pr = 0; pr < 4; ++pr) { f32x4 xv[2][2][2];
#pragma unroll
        for (int q = 0; q < 2; ++q) { const int am = pr * 2 + q, ai = am >> 2, m = am & 3; const float* xr = p.x_prompt + (size_t)(row0 + ai * 128 + m * 16) * 1024;
#pragma unroll
            for (int bj = 0; bj < 2; ++bj)
#pragma unroll
                for (int n = 0; n < 2; ++n) xv[q][bj][n] = *(const f32x4*)(xr + col0 + bj * 128 + n * 4); }
#pragma unroll
        for (int q = 0; q < 2; ++q) { const int am = pr * 2 + q, ai = am >> 2, m = am & 3; float ss = 0.f;
#pragma unroll
            for (int bj = 0; bj < 2; ++bj)
#pragma unroll
                for (int n = 0; n < 2; ++n) { const f32x4 r = xv[q][bj][n] + acc[ai][bj][m][n]; acc[ai][bj][m][n] = r; ss += r[0] * r[0] + r[1] * r[1] + r[2] * r[2] + r[3] * r[3]; }
            ss += __shfl_xor(ss, 16); ss += __shfl_xor(ss, 32);
            if (fq == 0) atomicAdd(rowss + row0 + ai * 128 + m * 16, ss); }
        asm volatile("" ::: "memory"); }
    asm volatile("s_waitcnt vmcnt(0)" ::: "memory");
    __syncthreads();
    if (tq_ == 0) { __hip_atomic_fetch_add(cnt, 1u, __ATOMIC_RELAXED, __HIP_MEMORY_SCOPE_AGENT); unsigned sp = 0;
        while (__hip_atomic_load(cnt, __ATOMIC_RELAXED, __HIP_MEMORY_SCOPE_AGENT) < 4u) { __builtin_amdgcn_s_sleep(1); if (++sp > (1u << 20)) break; } }
    __syncthreads();
    PG8_LAS float* S = (PG8_LAS float*)lds;
    if (tq_ < 256) { const unsigned tb = __hip_atomic_load((unsigned*)(rowss + u.pm * 256 + tq_), __ATOMIC_RELAXED, __HIP_MEMORY_SCOPE_AGENT); S[tq_] = rsqrtf(__uint_as_float(tb) * (1.0f / 1024.0f) + EPSN); }
    __syncthreads();
    f32x4 gn[2][2];
#pragma unroll
    for (int bj = 0; bj < 2; ++bj)
#pragma unroll
        for (int n = 0; n < 2; ++n) gn[bj][n] = *(const f32x4*)(p.norm_final + col0 + bj * 128 + n * 4);
#pragma unroll
    for (int ai = 0; ai < 2; ++ai)
#pragma unroll
        for (int m = 0; m < 4; ++m) { const float rs = S[wr * 64 + fr + ai * 128 + m * 16]; float* orow = p.out + (size_t)(row0 + ai * 128 + m * 16) * 1024 + col0;
#pragma unroll
            for (int bj = 0; bj < 2; ++bj)
#pragma unroll
                for (int n = 0; n < 2; ++n) *(f32x4*)(orow + bj * 128 + n * 4) = acc[ai][bj][m][n] * rs * gn[bj][n]; }
}
DI void gate_scale(const Params& p, f32x4 (&acc)[2][2][4][2], const MUnit& u, int which) {
    const int tq_ = otid(), wq_ = tq_ >> 6, wr = wq_ >> 2, wc = wq_ & 3, fr = tq_ & 15, fq = (tq_ >> 4) & 3;
    const int row0 = u.pm * 256 + wr * 64 + fr, col0 = u.pn * 256 + wc * 32 + 8 * fq;
    const u16* GS = (const u16*)(p.ws + W_GSC) + ((size_t)blockIdx.x * 3 + which) * 65536 + (size_t)(wr * 64 + fr) * 256 + wc * 32 + 8 * fq;
#pragma unroll
    for (int pr = 0; pr < 4; ++pr) { u32x4 ga[2][2], gb[2][2];
#pragma unroll
        for (int q = 0; q < 2; ++q) { const int am = pr * 2 + q, ai = am >> 2, m = am & 3;
#pragma unroll
            for (int bj = 0; bj < 2; ++bj) { const u16* zp = GS + (ai * 128 + m * 16) * 256 + bj * 128; ga[q][bj] = *(const u32x4*)zp; gb[q][bj] = *(const u32x4*)(zp + 65536); } }
#pragma unroll
        for (int q = 0; q < 2; ++q) { const int am = pr * 2 + q, ai = am >> 2, m = am & 3;
#pragma unroll
            for (int bj = 0; bj < 2; ++bj) { float f[8];
#pragma unroll
                for (int j = 0; j < 4; ++j) { f[2 * j] = (1.0f + __expf(-bflo(gb[q][bj][j]))) * __builtin_amdgcn_rcpf(1.0f + __expf(-bflo(ga[q][bj][j])));
                    f[2 * j + 1] = (1.0f + __expf(-bfhi(gb[q][bj][j]))) * __builtin_amdgcn_rcpf(1.0f + __expf(-bfhi(ga[q][bj][j]))); }
                acc[ai][bj][m][0] *= (f32x4){f[0], f[1], f[2], f[3]}; acc[ai][bj][m][1] *= (f32x4){f[4], f[5], f[6], f[7]}; } }
        asm volatile("" ::: "memory"); }
}
DI void gemm_multi(PG8_LAS unsigned char* lds, const Params& p, const GDesc d0, const GDesc d1, const GDesc d2, const GDesc d3, const MSched& S, size_t rsoff) {
    using namespace pg8;
    const int tid = otid(), wid = __builtin_amdgcn_readfirstlane(tid >> 6), lane = tid & 63, wr = wid >> 2, wc = wid & 3, fr = lane & 15, fq = lane >> 4;
    unsigned ra2[2], rb2[2], c2[2];
#pragma unroll
    for (int i = 0; i < 2; ++i) { int R, C; stage_rc(tid * 16 + i * 8192, R, C); ra2[i] = (unsigned)R * 2u; rb2[i] = (unsigned)((R & ~31) + perm32(R & 31)) * 2u; c2[i] = (unsigned)C * 2u; }
    const size_t kstep = (size_t)(BK * 2);
    const unsigned ldsw = (unsigned)wid * 1024u;
    const int aoff = lds_byte(wr * 64 + fr, fq * 8), boff = lds_byte(wc * 32 + fr, fq * 8);
#define PG8_SA(b, h) (((b) * 2 + (h)) * HTB)
#define PG8_SB(b, h) ((4 + (b) * 2 + (h)) * HTB)
#define PG8_STAGE(bufoff, gbase, voff) do { _Pragma("unroll") for (int _i = 0; _i < 2; ++_i) \
        __builtin_amdgcn_global_load_lds((const unsigned*)((const char*)(gbase) + (voff)[_i]), (PG8_LAS unsigned*)(lds + (bufoff) + ldsw + _i * 8192), 16, 0, 0); } while (0)
#define PG8_LDA(dst, b, h) do { _Pragma("unroll") for (int m = 0; m < 4; ++m) _Pragma("unroll") for (int k = 0; k < 2; ++k) dst[m][k] = *(const PG8_LAS bf16x8*)(lds + PG8_SA(b, h) + aoff + m * 2048 + k * 1024); } while (0)
#define PG8_LDB(dst, b, h) do { _Pragma("unroll") for (int n = 0; n < 2; ++n) _Pragma("unroll") for (int k = 0; k < 2; ++k) dst[n][k] = *(const PG8_LAS bf16x8*)(lds + PG8_SB(b, h) + boff + n * 2048 + k * 1024); } while (0)
#define PG8_MMA(ai, bj, At, Bt) do { __builtin_amdgcn_s_setprio(1); _Pragma("unroll") for (int m = 0; m < 4; ++m) _Pragma("unroll") for (int n = 0; n < 2; ++n) _Pragma("unroll") for (int k = 0; k < 2; ++k) \
        acc[ai][bj][m][n] = __builtin_amdgcn_mfma_f32_16x16x32_bf16(Bt[n][k], At[m][k], acc[ai][bj][m][n], 0, 0, 0); __builtin_amdgcn_s_setprio(0); } while (0)
#define PG8_WAIT_V(n) asm volatile("s_waitcnt vmcnt(" #n ")" ::: "memory")
#define PG8_WAIT_L(n) asm volatile("s_waitcnt lgkmcnt(" #n ")" ::: "memory")
#define PG8_BAR __builtin_amdgcn_s_barrier()
#define PG8_SCHED __builtin_amdgcn_sched_barrier(0)
#define GSEL(gi, f) ((gi) == 0 ? d0.f + 0 : ((gi) == 1 ? d1.f + 0 : ((gi) == 2 ? d2.f + 0 : d3.f + 0)))
    MUnit cur, nxt; int ui = 0;
    if (!S.next(0, cur)) return;
    f32x4 acc[2][2][4][2];
#pragma unroll
    for (int a = 0; a < 2; ++a)
#pragma unroll
        for (int b = 0; b < 2; ++b)
#pragma unroll
            for (int m = 0; m < 4; ++m)
#pragma unroll
                for (int n = 0; n < 2; ++n) acc[a][b][m][n] = (f32x4){0.f, 0.f, 0.f, 0.f};
    bf16x8 At[4][2], B0[2][2], B1[2][2];
    int Kc = GSEL(cur.gi, K); int modec = GSEL(cur.gi, mode);
    const char* cA = (const char*)GSEL(cur.gi, A) + (size_t)cur.pm * ((size_t)512 * Kc); const char* cB = (const char*)GSEL(cur.gi, Bt) + (size_t)cur.pn * ((size_t)512 * Kc);
    {
        const size_t hstep = (size_t)HALF * Kc * 2; unsigned vA[2], vB[2];
#pragma unroll
        for (int i = 0; i < 2; ++i) { vA[i] = ra2[i] * (unsigned)Kc + c2[i]; vB[i] = rb2[i] * (unsigned)Kc + c2[i]; }
        PG8_STAGE(PG8_SB(0, 0), cB, vB); PG8_STAGE(PG8_SA(0, 0), cA, vA); PG8_STAGE(PG8_SB(0, 1), cB + hstep, vB); PG8_STAGE(PG8_SA(0, 1), cA + hstep, vA);
        if (wr == 1) PG8_BAR;
        PG8_WAIT_V(4); PG8_BAR;
        PG8_STAGE(PG8_SB(1, 0), cB + kstep, vB); PG8_STAGE(PG8_SA(1, 0), cA + kstep, vA); PG8_STAGE(PG8_SB(1, 1), cB + hstep + kstep, vB);
        PG8_WAIT_V(6); PG8_BAR;
    }
    for (;;) {
        const bool has_next = S.next(ui + 1, nxt);
        const int Kn = has_next ? GSEL(nxt.gi, K) : Kc; const int moden = has_next ? GSEL(nxt.gi, mode) : modec;
        const char* nA = has_next ? (const char*)GSEL(nxt.gi, A) + (size_t)nxt.pm * ((size_t)512 * Kn) : cA; const char* nB = has_next ? (const char*)GSEL(nxt.gi, Bt) + (size_t)nxt.pn * ((size_t)512 * Kn) : cB;
        const int nt = Kc / BK; const size_t hstepc = (size_t)HALF * Kc * 2;
        unsigned vAc[2];
#pragma unroll
        for (int i = 0; i < 2; ++i) vAc[i] = ra2[i] * (unsigned)Kc + c2[i];
        for (int t = 0; t < nt; t += 2) {
            const bool last = (t == nt - 2);
            const int K2 = last ? Kn : Kc; const size_t hstep2 = (size_t)HALF * K2 * 2;
            unsigned vA2[2], vB2[2];
#pragma unroll
            for (int i = 0; i < 2; ++i) { vA2[i] = ra2[i] * (unsigned)K2 + c2[i]; vB2[i] = rb2[i] * (unsigned)K2 + c2[i]; }
            const char* a1 = cA + (size_t)(t + 1) * kstep;
            const char* a2 = last ? nA : cA + (size_t)(t + 2) * kstep; const char* b2 = last ? nB : cB + (size_t)(t + 2) * kstep;
            const char* a3 = a2 + kstep; const char* b3 = b2 + kstep;
            PG8_LDB(B0, 0, 0); PG8_SCHED; PG8_LDA(At, 0, 0); PG8_STAGE(PG8_SA(1, 1), a1 + hstepc, vAc);
            PG8_WAIT_L(8); PG8_BAR; PG8_WAIT_L(0); PG8_MMA(0, 0, At, B0); PG8_BAR; PG8_SCHED;
            PG8_LDB(B1, 0, 1); PG8_STAGE(PG8_SB(0, 0), b2, vB2);
            PG8_BAR; PG8_WAIT_L(0); PG8_MMA(0, 1, At, B1); PG8_BAR;
            PG8_LDA(At, 0, 1); PG8_STAGE(PG8_SA(0, 0), a2, vA2);
            PG8_BAR; PG8_WAIT_L(0); PG8_MMA(1, 0, At, B0); PG8_BAR; PG8_SCHED;
            PG8_STAGE(PG8_SB(0, 1), b2 + hstep2, vB2);
            PG8_WAIT_V(6); PG8_BAR; PG8_MMA(1, 1, At, B1); PG8_BAR;
            PG8_LDB(B0, 1, 0); PG8_SCHED; PG8_LDA(At, 1, 0); PG8_STAGE(PG8_SA(0, 1), a2 + hstep2, vA2);
            PG8_WAIT_L(8); PG8_BAR; PG8_WAIT_L(0); PG8_MMA(0, 0, At, B0); PG8_BAR; PG8_SCHED;
            PG8_LDB(B1, 1, 1); PG8_STAGE(PG8_SB(1, 0), b3, vB2);
            PG8_BAR; PG8_WAIT_L(0); PG8_MMA(0, 1, At, B1); PG8_BAR;
            PG8_LDA(At, 1, 1); PG8_STAGE(PG8_SA(1, 0), a3, vA2);
            PG8_BAR; PG8_WAIT_L(0); PG8_MMA(1, 0, At, B0); PG8_BAR; PG8_SCHED;
            PG8_STAGE(PG8_SB(1, 1), b3 + hstep2, vB2);
            PG8_WAIT_V(6); PG8_BAR; PG8_MMA(1, 1, At, B1); PG8_BAR;
            if (modec == 6 && (t == 2 || t == 10)) gate_scale(p, acc, cur, t == 2 ? 0 : 1);
        }
        if (modec != 5) epi_all(p, modec, acc, cur, rsoff);
        if (!has_next) break;
#pragma unroll
        for (int a = 0; a < 2; ++a)
#pragma unroll
            for (int b = 0; b < 2; ++b)
#pragma unroll
                for (int m = 0; m < 4; ++m)
#pragma unroll
                    for (int n = 0; n < 2; ++n) acc[a][b][m][n] = (f32x4){0.f, 0.f, 0.f, 0.f};
        cur = nxt; cA = nA; cB = nB; Kc = Kn; modec = moden; ++ui;
    }
    PG8_WAIT_V(0);
    if (wr == 0) PG8_BAR;
    PG8_BAR;
    if (modec == 5) epi_fused(p, lds, acc, cur, rsoff);
#undef GSEL
#undef PG8_SA
#undef PG8_SB
#undef PG8_STAGE
#undef PG8_LDA
#undef PG8_LDB
#undef PG8_MMA
#undef PG8_WAIT_V
#undef PG8_WAIT_L
#undef PG8_BAR
#undef PG8_SCHED
}

DI void wg_publish(unsigned* cnt) {
    asm volatile("s_waitcnt vmcnt(0)" ::: "memory");
    __syncthreads();
    if (threadIdx.x == 0) { __builtin_amdgcn_fence(__ATOMIC_RELEASE, "agent"); asm volatile("s_waitcnt vmcnt(0)" ::: "memory"); __hip_atomic_fetch_add(cnt, 1u, __ATOMIC_RELAXED, __HIP_MEMORY_SCOPE_AGENT); }
}
DI void wg_consume(unsigned* cnt, unsigned need) {
    if (threadIdx.x == 0) { unsigned sp = 0;
        while (__hip_atomic_load(cnt, __ATOMIC_RELAXED, __HIP_MEMORY_SCOPE_AGENT) < need) { __builtin_amdgcn_s_sleep(1); if (++sp > (1u << 20)) break; }
        __builtin_amdgcn_fence(__ATOMIC_ACQUIRE, "agent"); asm volatile("s_waitcnt vmcnt(0)" ::: "memory"); }
    __syncthreads();
}
DI void sk_range(f32x4 (&acc)[2], const u16* ap, const u16* bp0, const u16* bp1, int k0, int k1) {
#pragma unroll 8
    for (int k = k0; k < k1; k += 32) { const bf16x8 a = *(const bf16x8*)(ap + k), b0 = *(const bf16x8*)(bp0 + k), b1 = *(const bf16x8*)(bp1 + k);
        acc[0] = MFMA16(b0, a, acc[0]); acc[1] = MFMA16(b1, a, acc[1]); }
}
DI void skinny_tile(const Params& p, int mode, const u16* A, const u16* Bt, int grow0, int n0, size_t rsoff = 0) {
    const int tid = otid(), w = tid >> 6, lane = tid & 63, l15 = lane & 15, g4 = lane >> 4;
    f32x4 acc[2]; acc[0] = (f32x4){0.f, 0.f, 0.f, 0.f}; acc[1] = acc[0];
    const u16* ap = A + (size_t)(16 * w + l15) * 1024 + 8 * g4;
    const u16* bp0 = Bt + (size_t)(n0 + l15) * 1024 + 8 * g4; const u16* bp1 = bp0 + 16 * 1024;
    const size_t grow = (size_t)grow0 + 16 * w + l15;
    const u16* Z = (const u16*)(p.ws + W_Z);
    if (mode == 2) {
        sk_range(acc, ap, bp0, bp1, 0, 256);
#pragma unroll
        for (int which = 0; which < 2; ++which) {
#pragma unroll
            for (int jb = 0; jb < 2; ++jb) { const u16* zp = Z + grow * 8192 + C_ZG + which * 1024 + n0 + 16 * jb + 4 * g4; const u32x2 ga = *(const u32x2*)zp, gb = *(const u32x2*)(zp + 1024);
                acc[jb][0] *= (1.0f + __expf(-bflo(gb[0]))) * __builtin_amdgcn_rcpf(1.0f + __expf(-bflo(ga[0]))); acc[jb][1] *= (1.0f + __expf(-bfhi(gb[0]))) * __builtin_amdgcn_rcpf(1.0f + __expf(-bfhi(ga[0])));
                acc[jb][2] *= (1.0f + __expf(-bflo(gb[1]))) * __builtin_amdgcn_rcpf(1.0f + __expf(-bflo(ga[1]))); acc[jb][3] *= (1.0f + __expf(-bfhi(gb[1]))) * __builtin_amdgcn_rcpf(1.0f + __expf(-bfhi(ga[1]))); }
            if (which == 0) sk_range(acc, ap, bp0, bp1, 256, 768); else sk_range(acc, ap, bp0, bp1, 768, 1024); }
    } else sk_range(acc, ap, bp0, bp1, 0, 1024);
    float ss = 0.f;
#pragma unroll
    for (int jb = 0; jb < 2; ++jb) { const int n = n0 + 16 * jb + 4 * g4; const f32x4 v = acc[jb];
        if (mode == 0) { u32x2 wv = {pk2(v[0], v[1]), pk2(v[2], v[3])}; *(u32x2*)((u16*)(p.ws + W_Z) + grow * 8192 + n) = wv; }
        else if (mode == 1) { u32x2 wv = {pk2(v[0], v[1]), pk2(v[2], v[3])}; *(u32x2*)((u16*)(p.ws + W_MEMKV) + grow * 512 + n) = wv; *(f32x4*)(p.out + O_MKV + grow * 512 + n) = v; }
        else if (mode == 2) { const u32x2 gz = *(const u32x2*)(Z + grow * 8192 + C_ZG + 2048 + n);
            u32x2 wv = {pk2(v[0] * sigmoidf_(bflo(gz[0])), v[1] * sigmoidf_(bfhi(gz[0]))), pk2(v[2] * sigmoidf_(bflo(gz[1])), v[3] * sigmoidf_(bfhi(gz[1])))};
            *(u32x2*)((u16*)(p.ws + W_MERGED) + grow * 1024 + n) = wv; }
        else { const f32x4 r = *(const f32x4*)(p.x_sample + (grow - NTOK_P) * 1024 + n) + v; acc[jb] = r; ss += r[0] * r[0] + r[1] * r[1] + r[2] * r[2] + r[3] * r[3]; } }
    if (mode == 3) {
        float* rowss = (float*)(p.ws + W_ROWSS + rsoff); unsigned* cnt = (unsigned*)(p.ws + W_CNT) + 64 * 64;
        ss += __shfl_xor(ss, 16); ss += __shfl_xor(ss, 32); if (g4 == 0) atomicAdd(rowss + grow, ss);
        asm volatile("s_waitcnt vmcnt(0)" ::: "memory");
        __syncthreads();
        if (tid == 0) { __hip_atomic_fetch_add(cnt, 1u, __ATOMIC_RELAXED, __HIP_MEMORY_SCOPE_AGENT); unsigned sp = 0;
            while (__hip_atomic_load(cnt, __ATOMIC_RELAXED, __HIP_MEMORY_SCOPE_AGENT) < 32u) { __builtin_amdgcn_s_sleep(1); if (++sp > (1u << 20)) break; } }
        __syncthreads();
        const unsigned tb = __hip_atomic_load((unsigned*)(rowss + grow), __ATOMIC_RELAXED, __HIP_MEMORY_SCOPE_AGENT); const float rs = rsqrtf(__uint_as_float(tb) * (1.0f / 1024.0f) + EPSN);
#pragma unroll
        for (int jb = 0; jb < 2; ++jb) { const int n = n0 + 16 * jb + 4 * g4; *(f32x4*)(p.out + grow * 1024 + n) = acc[jb] * rs * *(const f32x4*)(p.norm_final + n); } }
}
DI void phase_skinny(const Params& p, int ph, size_t rsoff) {
    if (ph == 1) { for (int it = blockIdx.x; it < 256; it += gridDim.x) {
            if (it < 256) skinny_tile(p, 0, (const u16*)(p.ws + W_H) + (size_t)NTOK_P * 1024, (const u16*)(p.ws + W_WINT), NTOK_P, it * 32);
            else { const int q = it - 256, rg = q >> 4, cb = q & 15; skinny_tile(p, 1, (const u16*)(p.ws + W_HM) + (size_t)rg * 128 * 1024, (const u16*)(p.ws + W_WMEMT), rg * 128, cb * 32); } } }
    else if (ph == 5) { for (int it = blockIdx.x; it < 32; it += gridDim.x) skinny_tile(p, 2, (const u16*)(p.ws + W_UA) + (size_t)NTOK_P * 1024, (const u16*)(p.ws + W_WAT), NTOK_P, it * 32); }
    else { for (int it = blockIdx.x; it < 32; it += gridDim.x) skinny_tile(p, 3, (const u16*)(p.ws + W_MERGED) + (size_t)NTOK_P * 1024, (const u16*)(p.ws + W_WOUTT), NTOK_P, it * 32, rsoff); }
}

struct AttnItem { int is_mem, b, h, grp, dil, r, nb; };
struct AttnRegs { uint4 k[4], va[2], vb[2]; bf16x8 q0, q1; };
DI AttnItem attn_decode(int idx  ) {
    AttnItem a; a.grp = 0; a.dil = 1; a.r = 0;
    if (idx >= 1536) { idx -= 1536; a.is_mem = 1; a.b = idx >> 8; a.h = (idx >> 6) & 3; a.nb = idx & 63; }
    else { a.is_mem = 0; a.grp = idx >> 9; const int rem = idx & 511; a.b = rem >> 8; a.h = (rem >> 6) & 3; const int c = rem & 63; a.dil = a.grp == 0 ? 1 : (a.grp == 1 ? 4 : 16);
           const int nbc = 64 / a.dil; a.r = c / nbc; a.nb = c % nbc; }
    return a;
}
DI size_t attn_qrow(const AttnItem& a, int qi) { return a.is_mem ? ((size_t)a.b * 8192 + a.nb * 128 + qi) : ((size_t)a.b * 8192 + (size_t)(a.nb * 128 + qi) * a.dil + a.r); }
DI void attn_load(const Params& p, const AttnItem& a, AttnRegs& R) {
    const u16* Z = (const u16*)(p.ws + W_Z); const u16* MK = (const u16*)(p.ws + W_MEMKV);
    const int tid = otid(), w = tid >> 6, lane = tid & 63, l15 = lane & 15, g4 = lane >> 4;
    const uint4 z4 = {0u, 0u, 0u, 0u};
#pragma unroll
    for (int it = 0; it < 4; ++it) { const int c = tid + 512 * it, kr = c >> 3, seg = c & 7; uint4 v = z4;
        if (a.is_mem) v = *(const uint4*)(MK + (size_t)(a.b * 256 + kr) * 512 + a.h * 64 + seg * 8);
        else { const int uu = (a.nb - 1) * 128 + kr; if (uu >= 0) v = *(const uint4*)(Z + ((size_t)a.b * 8192 + (size_t)uu * a.dil + a.r) * 8192 + C_KA + a.grp * 256 + a.h * 64 + seg * 8); }
        R.k[it] = v; }
#pragma unroll
    for (int it = 0; it < 2; ++it) { const int un = tid + 512 * it, seg = un & 7, kp = un >> 3; uint4 va = z4, vb = z4;
        if (a.is_mem) { const u16* s = MK + (size_t)(a.b * 256 + 2 * kp) * 512 + 256 + a.h * 64 + seg * 8; va = *(const uint4*)s; vb = *(const uint4*)(s + 512); }
        else { const int uu = (a.nb - 1) * 128 + 2 * kp; if (uu >= 0) { const u16* s = Z + ((size_t)a.b * 8192 + (size_t)uu * a.dil + a.r) * 8192 + C_VA + a.grp * 256 + a.h * 64 + seg * 8;
                   va = *(const uint4*)s; vb = *(const uint4*)(s + (size_t)a.dil * 8192); } }
        R.va[it] = va; R.vb[it] = vb; }
    const u16* qp = Z + attn_qrow(a, 16 * w + l15) * 8192 + (a.is_mem ? C_QM : C_QA + a.grp * 256) + a.h * 64 + g4 * 8;
    R.q0 = *(const bf16x8*)qp; R.q1 = *(const bf16x8*)(qp + 32);
}
DI void attn_stage(char* smem, const AttnRegs& R) {
    const int tid = otid();
    u16* Ks = (u16*)smem;
    unsigned* VT = (unsigned*)(smem + 36864);
#pragma unroll
    for (int it = 0; it < 4; ++it) { const int c = tid + 512 * it, kr = c >> 3, seg = c & 7; *(uint4*)(Ks + kr * 72 + seg * 8) = R.k[it]; }
#pragma unroll
    for (int it = 0; it < 2; ++it) { const int un = tid + 512 * it, seg = un & 7, kp = un >> 3; const uint4 va = R.va[it], vb = R.vb[it];
        unsigned* d = VT + (seg * 8) * 129 + kp;
        d[0 * 129] = (va.x & 0xffffu) | (vb.x << 16); d[1 * 129] = (va.x >> 16) | (vb.x & 0xffff0000u);
        d[2 * 129] = (va.y & 0xffffu) | (vb.y << 16); d[3 * 129] = (va.y >> 16) | (vb.y & 0xffff0000u);
        d[4 * 129] = (va.z & 0xffffu) | (vb.z << 16); d[5 * 129] = (va.z >> 16) | (vb.z & 0xffff0000u);
        d[6 * 129] = (va.w & 0xffffu) | (vb.w << 16); d[7 * 129] = (va.w >> 16) | (vb.w & 0xffff0000u); }
}
DI void attn_compute(const Params& p, char* smem, const AttnItem& a, const bf16x8 qf0, const bf16x8 qf1) {
    const u16* Z = (const u16*)(p.ws + W_Z);
    const int tid = otid(), w = tid >> 6, lane = tid & 63, l15 = lane & 15, g4 = lane >> 4;
    const u16* Ks = (const u16*)smem; const unsigned* VT = (const unsigned*)(smem + 36864);
    const bool is_mem = a.is_mem != 0; const int nb = a.nb, h = a.h, grp = a.grp;
    const int qi = 16 * w + l15; const size_t qrow = attn_qrow(a, qi);
    f32x4 s[16];
#pragma unroll
    for (int kg = 0; kg < 4; ++kg) { bf16x8 ka[4][2];
#pragma unroll
        for (int i = 0; i < 4; ++i) { const u16* kp_ = Ks + ((kg * 4 + i) * 16 + l15) * 72 + g4 * 8; ka[i][0] = *(const bf16x8*)kp_; ka[i][1] = *(const bf16x8*)(kp_ + 32); }
        __builtin_amdgcn_sched_barrier(0);
#pragma unroll
        for (int i = 0; i < 4; ++i) { f32x4 acc = {0.f, 0.f, 0.f, 0.f}; acc = MFMA16(ka[i][0], qf0, acc); acc = MFMA16(ka[i][1], qf1, acc); s[kg * 4 + i] = acc; }
        __builtin_amdgcn_sched_barrier(0); }
    const float c1 = 0.125f * 1.4426950408889634f;
    float mx = -1e30f;
#pragma unroll
    for (int kb = 0; kb < 16; ++kb)
#pragma unroll
        for (int j = 0; j < 4; ++j) { const float v = s[kb][j] * c1; s[kb][j] = v; mx = fmaxf(mx, v); }
    mx = fmaxf(mx, __shfl_xor(mx, 16)); mx = fmaxf(mx, __shfl_xor(mx, 32));
    float l = 0.f;
#pragma unroll
    for (int kb = 0; kb < 16; ++kb)
#pragma unroll
        for (int j = 0; j < 4; ++j) { const float e = __builtin_amdgcn_exp2f(s[kb][j] - mx); s[kb][j] = e; l += e; }
    l += __shfl_xor(l, 16); l += __shfl_xor(l, 32);
    f32x4 o[4];
#pragma unroll
    for (int db = 0; db < 4; ++db) o[db] = (f32x4){0.f, 0.f, 0.f, 0.f};
#pragma unroll
    for (int k2 = 0; k2 < 4; ++k2) { unsigned vr[2][4][4];
#pragma unroll
        for (int q = 0; q < 2; ++q)
#pragma unroll
            for (int db = 0; db < 4; ++db) { const unsigned* vp = VT + (db * 16 + l15) * 129 + 16 * (2 * k2 + q) + 2 * g4; vr[q][db][0] = vp[0]; vr[q][db][1] = vp[1]; vr[q][db][2] = vp[8]; vr[q][db][3] = vp[9]; }
        const bf16x8 pf0 = pack8(s[4 * k2], s[4 * k2 + 1]), pf1 = pack8(s[4 * k2 + 2], s[4 * k2 + 3]);
        __builtin_amdgcn_sched_barrier(0);
#pragma unroll
        for (int db = 0; db < 4; ++db) o[db] = MFMA16(mk8(vr[0][db][0], vr[0][db][1], vr[0][db][2], vr[0][db][3]), pf0, o[db]);
#pragma unroll
        for (int db = 0; db < 4; ++db) o[db] = MFMA16(mk8(vr[1][db][0], vr[1][db][1], vr[1][db][2], vr[1][db][3]), pf1, o[db]);
        __builtin_amdgcn_sched_barrier(0); }
    const float inv = 1.0f / l;
    if (is_mem) { u16* UM = (u16*)(p.ws + W_UA) + 768;
#pragma unroll
        for (int db = 0; db < 4; ++db) { const int c = h * 64 + db * 16 + 4 * g4; const u32x2 gw = *(const u32x2*)(Z + qrow * 8192 + C_GM + c);
            u32x2 wv = {pk2(o[db][0] * inv * siluf_(bflo(gw[0])), o[db][1] * inv * siluf_(bfhi(gw[0]))), pk2(o[db][2] * inv * siluf_(bflo(gw[1])), o[db][3] * inv * siluf_(bfhi(gw[1])))};
            *(u32x2*)(UM + qrow * 1024 + c) = wv; } }
    else { u16* OA = (u16*)(p.ws + W_OA); float* LSE = (float*)(p.ws + W_LSE); const size_t ro = (size_t)grp * NTOK + qrow;
#pragma unroll
        for (int db = 0; db < 4; ++db) { u32x2 wv = {pk2(o[db][0] * inv, o[db][1] * inv), pk2(o[db][2] * inv, o[db][3] * inv)};
            *(u32x2*)(OA + ro * 256 + h * 64 + db * 16 + 4 * g4) = wv; }
        if (g4 == 0) LSE[ro * 4 + h] = mx * 0.6931471805599453f + __logf(l); }
}

DI void hg_local(const Params& p, char* smem, int item) {
    const u16* Z = (const u16*)(p.ws + W_Z);
    const int tid = otid(), w = tid >> 6, lane = tid & 63, l15 = lane & 15, g4 = lane >> 4;
    const int bh = item >> 5, sc = item & 31, b = bh >> 2, h = bh & 3;
    const size_t row0 = (size_t)b * 8192 + sc * 256;
    u16* KT = (u16*)smem;
    u16* VT = (u16*)(smem + 34816);
    float* segprod = (float*)(smem + 69632);
    float* carry = segprod + 512;
    const int dk = tid & 127, seg = tid >> 7;
    const float lb = 1.0f / (1.0f + __expf(p.lb_logits[512 + h * 128 + dk] - p.lb_logits[h * 128 + dk]));
    if (tid < 128) carry[tid] = 1.0f;
    f32x4 S[8];
#pragma unroll
    for (int i = 0; i < 8; ++i) S[i] = (f32x4){0.f, 0.f, 0.f, 0.f};
    for (int c = 1; c >= 0; --c) {
        const size_t rbase = row0 + c * 128 + seg * 32;
        float f[32]; float prod = 1.0f;
#pragma unroll
        for (int i = 0; i < 32; ++i) { const float fb = bf2f(Z[(rbase + i) * 8192 + C_FB + h * 128 + dk]); f[i] = lb + (1.0f - lb) * sigmoidf_(fb); prod *= f[i]; }
        segprod[seg * 128 + dk] = prod;
#pragma unroll
        for (int i8 = 0; i8 < 4; ++i8) { unsigned wv[4];
#pragma unroll
            for (int j = 0; j < 4; ++j) { const unsigned lo = Z[(rbase + i8 * 8 + 2 * j) * 8192 + C_IB + h * 128 + dk], hi = Z[(rbase + i8 * 8 + 2 * j + 1) * 8192 + C_IB + h * 128 + dk]; wv[j] = lo | (hi << 16); }
            *(u32x4*)(VT + dk * 136 + seg * 32 + i8 * 8) = (u32x4){wv[0], wv[1], wv[2], wv[3]}; }
        __syncthreads();
        float run = carry[dk];
        for (int s2 = seg + 1; s2 < 4; ++s2) run *= segprod[s2 * 128 + dk];
#pragma unroll
        for (int i8 = 3; i8 >= 0; --i8) { float kt[8];
#pragma unroll
            for (int j = 7; j >= 0; --j) { const int i = i8 * 8 + j; kt[j] = (1.0f - f[i]) * run; run *= f[i]; }
            *(u32x4*)(KT + dk * 136 + seg * 32 + i8 * 8) = (u32x4){pk2(kt[0], kt[1]), pk2(kt[2], kt[3]), pk2(kt[4], kt[5]), pk2(kt[6], kt[7])}; }
        __syncthreads();
#pragma unroll
        for (int ks = 0; ks < 4; ++ks) { const bf16x8 bv = *(const bf16x8*)(VT + (16 * w + l15) * 136 + ks * 32 + g4 * 8); bf16x8 av[8];
#pragma unroll
            for (int blk = 0; blk < 8; ++blk) av[blk] = *(const bf16x8*)(KT + (16 * blk + l15) * 136 + ks * 32 + g4 * 8);
            __builtin_amdgcn_sched_barrier(0);
#pragma unroll
            for (int blk = 0; blk < 8; ++blk) S[blk] = MFMA16(av[blk], bv, S[blk]);
            __builtin_amdgcn_sched_barrier(0); }
        __syncthreads();
        if (tid < 128) carry[tid] = carry[tid] * segprod[tid] * segprod[128 + tid] * segprod[256 + tid] * segprod[384 + tid];
        __syncthreads();
    }
    float* ASC = (float*)(p.ws + W_ASC); float* SLOC = (float*)(p.ws + W_SLOC) + (size_t)item * 16384;
    if (tid < 128) ASC[item * 128 + tid] = carry[tid];
#pragma unroll
    for (int blk = 0; blk < 8; ++blk)
#pragma unroll
        for (int j = 0; j < 4; ++j) SLOC[(16 * blk + 4 * g4 + j) * 128 + 16 * w + l15] = S[blk][j];
    asm volatile("s_waitcnt vmcnt(0)" ::: "memory");
    __syncthreads();
    if (tid == 0) { __builtin_amdgcn_fence(__ATOMIC_RELEASE, "agent"); asm volatile("s_waitcnt vmcnt(0)" ::: "memory");
        __hip_atomic_fetch_add((unsigned*)(p.ws + W_BAR), 1u, __ATOMIC_RELAXED, __HIP_MEMORY_SCOPE_AGENT); }
}

DI void hg_out(const Params& p, char* smem, int item) {
    const u16* Z = (const u16*)(p.ws + W_Z);
    const int tid = otid(), w = tid >> 6, lane = tid & 63, l15 = lane & 15, g4 = lane >> 4;
    const int bh = item >> 5, sc = item & 31, b = bh >> 2, h = bh & 3;
    const size_t row0 = (size_t)b * 8192 + sc * 256;
    u16* QT = (u16*)smem;
    u16* KH = (u16*)(smem + 8704);
    u16* KT = (u16*)(smem + 17408);
    u16* VT = (u16*)(smem + 27648);
    float* plast = (float*)(smem + 37888);
    float* tqp = plast + 128;
    float* part = tqp + 512;
    const int dk = tid & 127, tq = tid >> 7;
    const float lb = 1.0f / (1.0f + __expf(p.lb_logits[512 + h * 128 + dk] - p.lb_logits[h * 128 + dk]));
    f32x4 S[8];
    { const float* ss = (const float*)(p.ws + W_SSTART) + (size_t)item * 16384;
#pragma unroll
      for (int blk = 0; blk < 8; ++blk)
#pragma unroll
          for (int j = 0; j < 4; ++j) S[blk][j] = ss[(16 * blk + 4 * g4 + j) * 128 + 16 * w + l15]; }
    const f32x4 gain = *(const f32x4*)(p.norm_hgrn + h * 128 + 16 * w + 4 * g4);
    u16* UB = (u16*)(p.ws + W_UA) + 256;
    u16 rf[8], rq[8], rv[8];
#pragma unroll
    for (int j = 0; j < 8; ++j) { const u16* zr = Z + (row0 + tq * 8 + j) * 8192 + h * 128 + dk; rf[j] = zr[C_FB]; rq[j] = zr[C_QB]; rv[j] = zr[C_IB]; }
    for (int ch = 0; ch < 8; ++ch) {
        float f[8], P[8], qv[8]; float prod = 1.0f;
#pragma unroll
        for (int j = 0; j < 8; ++j) { f[j] = lb + (1.0f - lb) * sigmoidf_(bf2f(rf[j])); prod *= f[j]; P[j] = prod; qv[j] = siluf_(bf2f(rq[j])); }
        tqp[tq * 128 + dk] = prod;
        *(u32x4*)(VT + dk * 40 + tq * 8) = (u32x4){(unsigned)rv[0] | ((unsigned)rv[1] << 16), (unsigned)rv[2] | ((unsigned)rv[3] << 16), (unsigned)rv[4] | ((unsigned)rv[5] << 16), (unsigned)rv[6] | ((unsigned)rv[7] << 16)};
        if (ch < 7) {
#pragma unroll
            for (int j = 0; j < 8; ++j) { const u16* zr = Z + (row0 + (ch + 1) * 32 + tq * 8 + j) * 8192 + h * 128 + dk; rf[j] = zr[C_FB]; rq[j] = zr[C_QB]; rv[j] = zr[C_IB]; } }
        __syncthreads();
        float pbase = 1.0f;
        for (int t2 = 0; t2 < tq; ++t2) pbase *= tqp[t2 * 128 + dk];
        const float ptot = tqp[dk] * tqp[128 + dk] * tqp[256 + dk] * tqp[384 + dk];
        float kt[8];
#pragma unroll
        for (int j = 0; j < 8; ++j) { const float Pj = pbase * P[j], ipj = __builtin_amdgcn_rcpf(Pj), kk = 1.0f - f[j];
            QT[(tq * 8 + j) * 136 + dk] = f2bf(qv[j] * Pj); KH[(tq * 8 + j) * 136 + dk] = f2bf(kk * ipj); kt[j] = kk * ptot * ipj; }
        *(u32x4*)(KT + dk * 40 + tq * 8) = (u32x4){pk2(kt[0], kt[1]), pk2(kt[2], kt[3]), pk2(kt[4], kt[5]), pk2(kt[6], kt[7])};
        if (tq == 0) plast[dk] = ptot;
        __syncthreads();
        f32x4 a00 = {0.f, 0.f, 0.f, 0.f}, a01 = a00, a11 = a00;
#pragma unroll
        for (int ks = 0; ks < 4; ++ks) { const int off = ks * 32 + g4 * 8;
            const bf16x8 k0 = *(const bf16x8*)(KH + l15 * 136 + off), k1 = *(const bf16x8*)(KH + (16 + l15) * 136 + off);
            const bf16x8 q0 = *(const bf16x8*)(QT + l15 * 136 + off), q1 = *(const bf16x8*)(QT + (16 + l15) * 136 + off);
            a00 = MFMA16(k0, q0, a00); a01 = MFMA16(k0, q1, a01); a11 = MFMA16(k1, q1, a11); }
#pragma unroll
        for (int j = 0; j < 4; ++j) { const bool ok = (4 * g4 + j) <= l15; a00[j] = ok ? a00[j] : 0.f; a11[j] = ok ? a11[j] : 0.f; }
        f32x4 o0 = {0.f, 0.f, 0.f, 0.f}, o1 = o0;
#pragma unroll
        for (int ks = 0; ks < 4; ++ks) { const bf16x8 sb = pack8(S[2 * ks], S[2 * ks + 1]);
            const u16* q0p = QT + l15 * 136 + ks * 32 + 4 * g4; const u16* q1p = q0p + 16 * 136;
            const u32x2 a = *(const u32x2*)q0p, bq = *(const u32x2*)(q0p + 16), c = *(const u32x2*)q1p, d = *(const u32x2*)(q1p + 16);
            o0 = MFMA16(sb, mk8(a[0], a[1], bq[0], bq[1]), o0); o1 = MFMA16(sb, mk8(c[0], c[1], d[0], d[1]), o1); }
        { const u16* vp = VT + (16 * w + l15) * 40 + 4 * g4; const u32x2 vlo = *(const u32x2*)vp, vhi = *(const u32x2*)(vp + 16);
          const bf16x8 va = mk8(vlo[0], vlo[1], vhi[0], vhi[1]); const f32x4 zz = {0.f, 0.f, 0.f, 0.f};
          o0 = MFMA16(va, pack8(a00, zz), o0); o1 = MFMA16(va, pack8(a01, a11), o1); }
        { const bf16x8 vb = *(const bf16x8*)(VT + (16 * w + l15) * 40 + g4 * 8);
#pragma unroll
          for (int blk = 0; blk < 8; ++blk) { const f32x4 pl = *(const f32x4*)(plast + 16 * blk + 4 * g4);
              S[blk] = MFMA16(*(const bf16x8*)(KT + (16 * blk + l15) * 40 + g4 * 8), vb, S[blk] * pl); } }
        { float q0 = o0[0] * o0[0] + o0[1] * o0[1] + o0[2] * o0[2] + o0[3] * o0[3], q1 = o1[0] * o1[0] + o1[1] * o1[1] + o1[2] * o1[2] + o1[3] * o1[3];
          q0 += __shfl_xor(q0, 16); q0 += __shfl_xor(q0, 32); q1 += __shfl_xor(q1, 16); q1 += __shfl_xor(q1, 32);
          if (g4 == 0) { part[w * 32 + l15] = q0; part[w * 32 + 16 + l15] = q1; } }
        __syncthreads();
#pragma unroll
        for (int tb = 0; tb < 2; ++tb) { const int t = 16 * tb + l15; float tot = 0.f;
#pragma unroll
            for (int ww = 0; ww < 8; ++ww) tot += part[ww * 32 + t];
            const float rs = rsqrtf(tot * (1.0f / 128.0f) + EPSN); const size_t row = row0 + ch * 32 + t; const f32x4 o = tb ? o1 : o0;
            const u32x2 gw = *(const u32x2*)(Z + row * 8192 + C_GB + h * 128 + 16 * w + 4 * g4);
            u32x2 wv = {pk2(o[0] * rs * gain[0] * siluf_(bflo(gw[0])), o[1] * rs * gain[1] * siluf_(bfhi(gw[0]))),
                        pk2(o[2] * rs * gain[2] * siluf_(bflo(gw[1])), o[3] * rs * gain[3] * siluf_(bfhi(gw[1])))};
            *(u32x2*)(UB + row * 1024 + h * 128 + 16 * w + 4 * g4) = wv; }
    }
    __syncthreads();
}

DI void dec_attn(const Params& p, char* smem, int item) {
    const u16* Z = (const u16*)(p.ws + W_Z);
    int b, src, h, part, np;
    const int tid = otid(), w = tid >> 6, lane = tid & 63, r = lane >> 4, c = lane & 15;
    if (item < 384) { b = item / 3; src = item - 3 * b; h = w & 3; part = w >> 2; np = 2; }
    else { const int q = item - 384; b = q >> 1; src = 3; h = 2 * (q & 1) + (w & 1); part = w >> 1; np = 4; }
    float* po = (float*)smem;
    float* ml = po + 512;
    const int dil = src == 0 ? 1 : (src == 1 ? 4 : 16), L = src == 0 ? 128 : (src == 1 ? 512 : 2048);
    const float* cw1 = p.c_w1; const float* cw2 = p.c_w2; const float* cw3 = p.c_w3; const float* cwm = p.c_mem;
    const float* cache = src == 0 ? cw1 + 0 : (src == 1 ? cw2 + 0 : (src == 2 ? cw3 + 0 : cwm + 0));
    const size_t brow = (size_t)b * (src == 3 ? 256 : L);
    const u16* zrow = Z + (size_t)(NTOK_P + b) * 8192;
    const int qcol = (src == 3 ? C_QM : C_QA + src * 256) + h * 64;
    const u32x2 qw = *(const u32x2*)(zrow + qcol + c * 4);
    const float q0 = bflo(qw[0]) * 0.125f, q1 = bfhi(qw[0]) * 0.125f, q2 = bflo(qw[1]) * 0.125f, q3 = bfhi(qw[1]) * 0.125f;
    const int j0 = part * 64;
    float m_run, l_run; float4 o = {0.f, 0.f, 0.f, 0.f};
    {
        float4 K[16], V[16];
#pragma unroll
        for (int it = 0; it < 16; ++it) { const int j = j0 + it * 4 + r; const int row = src == 3 ? j : L - dil * (j + 1);
            const float* kp = cache + (brow + row) * 512 + h * 64 + c * 4; K[it] = *(const float4*)kp; V[it] = *(const float4*)(kp + 256); }
        float s[16]; float mc = -1e30f;
#pragma unroll
        for (int it = 0; it < 16; ++it) { float d = K[it].x * q0 + K[it].y * q1 + K[it].z * q2 + K[it].w * q3;
            d += __shfl_xor(d, 1); d += __shfl_xor(d, 2); d += __shfl_xor(d, 4); d += __shfl_xor(d, 8); s[it] = d; mc = fmaxf(mc, d); }
        mc = fmaxf(mc, __shfl_xor(mc, 16)); mc = fmaxf(mc, __shfl_xor(mc, 32));
        m_run = mc; l_run = 0.f;
#pragma unroll
        for (int it = 0; it < 16; ++it) { const float pe = __expf(s[it] - mc); l_run += pe; o.x += pe * V[it].x; o.y += pe * V[it].y; o.z += pe * V[it].z; o.w += pe * V[it].w; }
    }
    l_run += __shfl_xor(l_run, 16); l_run += __shfl_xor(l_run, 32);
    o.x += __shfl_xor(o.x, 16); o.x += __shfl_xor(o.x, 32); o.y += __shfl_xor(o.y, 16); o.y += __shfl_xor(o.y, 32);
    o.z += __shfl_xor(o.z, 16); o.z += __shfl_xor(o.z, 32); o.w += __shfl_xor(o.w, 16); o.w += __shfl_xor(o.w, 32);
    if (r == 0) *(float4*)(po + w * 64 + c * 4) = o;
    if (lane == 0) { ml[w * 2] = m_run; ml[w * 2 + 1] = l_run; }
    __syncthreads();
    if (part == 0 && r == 0) {
        const int pstride = src == 3 ? 2 : 4;
        float sn = -1e30f; float4 vn = {0.f, 0.f, 0.f, 0.f};
        if (src < 3) { const u32x2 kw = *(const u32x2*)(zrow + C_KA + src * 256 + h * 64 + c * 4);
            float d = bflo(kw[0]) * q0 + bfhi(kw[0]) * q1 + bflo(kw[1]) * q2 + bfhi(kw[1]) * q3;
            d += __shfl_xor(d, 1); d += __shfl_xor(d, 2); d += __shfl_xor(d, 4); d += __shfl_xor(d, 8); sn = d;
            const u32x2 vw = *(const u32x2*)(zrow + C_VA + src * 256 + h * 64 + c * 4); vn = (float4){bflo(vw[0]), bfhi(vw[0]), bflo(vw[1]), bfhi(vw[1])}; }
        float M = sn;
        for (int k = 0; k < np; ++k) M = fmaxf(M, ml[(w + pstride * k) * 2]);
        const float wn = src < 3 ? __expf(sn - M) : 0.f;
        float l = wn; float4 ov = {wn * vn.x, wn * vn.y, wn * vn.z, wn * vn.w};
        for (int k = 0; k < np; ++k) { const int ww = w + pstride * k; const float wk = __expf(ml[ww * 2] - M); const float4 ok = *(const float4*)(po + ww * 64 + c * 4);
            l += wk * ml[ww * 2 + 1]; ov.x += wk * ok.x; ov.y += wk * ok.y; ov.z += wk * ok.z; ov.w += wk * ok.w; }
        const float inv = 1.0f / l; ov.x *= inv; ov.y *= inv; ov.z *= inv; ov.w *= inv; const size_t tok = NTOK_P + b;
        if (src < 3) { u32x2 wv = {pk2(ov.x, ov.y), pk2(ov.z, ov.w)}; *(u32x2*)((u16*)(p.ws + W_OA) + ((size_t)src * NTOK + tok) * 256 + h * 64 + c * 4) = wv;
            if (c == 0) ((float*)(p.ws + W_LSE))[((size_t)src * NTOK + tok) * 4 + h] = M + __logf(l); }
        else { const u32x2 gw = *(const u32x2*)(zrow + C_GM + h * 64 + c * 4);
            u32x2 wv = {pk2(ov.x * siluf_(bflo(gw[0])), ov.y * siluf_(bfhi(gw[0]))), pk2(ov.z * siluf_(bflo(gw[1])), ov.w * siluf_(bfhi(gw[1])))};
            *(u32x2*)((u16*)(p.ws + W_UA) + tok * 1024 + 768 + h * 64 + c * 4) = wv; } }
    __syncthreads();
}

DI void hg_step(const Params& p, char* smem, int item) {
    const u16* Z = (const u16*)(p.ws + W_Z);
    const int b = item >> 2, h = item & 3, tid = otid();
    const u16* zrow = Z + (size_t)(NTOK_P + b) * 8192;
    float* sf = (float*)smem; float* sq = sf + 128; float* sv = sq + 128; float* red = sv + 128;
    float* sss = red + 2048;
    if (tid < 128) { const int c = h * 128 + tid; const float lb = 1.0f / (1.0f + __expf(p.lb_logits[512 + c] - p.lb_logits[c]));
        sf[tid] = lb + (1.0f - lb) * sigmoidf_(bf2f(zrow[C_FB + c])); sq[tid] = siluf_(bf2f(zrow[C_QB + c])); }
    else if (tid < 256) sv[tid - 128] = bf2f(zrow[C_IB + h * 128 + tid - 128]);
    __syncthreads();
    const int c4 = (tid & 31) * 4, r0 = tid >> 5;
    const float* S0 = p.st_hgrn + (size_t)item * 16384; float* SO = p.out + O_HGS + (size_t)item * 16384;
    const float4 v4 = *(const float4*)(sv + c4);
    float4 oa = {0.f, 0.f, 0.f, 0.f};
#pragma unroll
    for (int i = 0; i < 8; ++i) { const int dkk = r0 + 16 * i; const float f = sf[dkk], k = 1.0f - f, q = sq[dkk];
        float4 s = *(const float4*)(S0 + dkk * 128 + c4);
        s.x = f * s.x + k * v4.x; s.y = f * s.y + k * v4.y; s.z = f * s.z + k * v4.z; s.w = f * s.w + k * v4.w;
        *(float4*)(SO + dkk * 128 + c4) = s;
        oa.x += s.x * q; oa.y += s.y * q; oa.z += s.z * q; oa.w += s.w * q; }
    *(float4*)(red + r0 * 128 + c4) = oa;
    __syncthreads();
    float o = 0.f;
    if (tid < 128) {
#pragma unroll
        for (int r = 0; r < 16; ++r) o += red[r * 128 + tid];
        const float q = wave_sum(o * o); if ((tid & 63) == 0) sss[tid >> 6] = q; }
    __syncthreads();
    if (tid < 128) { const float rs = rsqrtf((sss[0] + sss[1]) * (1.0f / 128.0f) + EPSN); const int c = h * 128 + tid;
        ((u16*)(p.ws + W_UA))[(size_t)(NTOK_P + b) * 1024 + 256 + c] = f2bf(o * rs * p.norm_hgrn[c] * siluf_(bf2f(zrow[C_GB + c]))); }
    __syncthreads();
}

DI void copy_rows_all(const Params& p) {
    const u16* Z = (const u16*)(p.ws + W_Z);
    const int tid = otid();
#pragma unroll
    for (int i = 0; i < 6; ++i) { size_t q = ((size_t)i * gridDim.x + blockIdx.x) * 512 + tid;
        const bool ok = q < 737280; if (!ok) q = 0;
        size_t oo; int g, L = 128; bool samp = false;
        if (q < 32768) { g = 0; L = 128; oo = O_W1P; } else if (q < 163840) { q -= 32768; g = 1; L = 512; oo = O_W2P; } else if (q < 688128) { q -= 163840; g = 2; L = 2048; oo = O_W3P; }
        else { q -= 688128; g = (int)(q >> 14); q &= 16383; samp = true; oo = g == 0 ? O_W1S : (g == 1 ? O_W2S : O_W3S); }
        const size_t e = q * 4; const int hd = (int)(e & 255), kv = (int)((e >> 8) & 1); size_t zr;
        if (samp) zr = NTOK_P + (e >> 9); else { const size_t bj = e >> 9; const int lg = g == 0 ? 7 : (g == 1 ? 9 : 11); const int bb = (int)(bj >> lg), j = (int)(bj & (size_t)(L - 1)); zr = (size_t)bb * 8192 + (8192 - L + j); }
        const u32x2 wv = *(const u32x2*)(Z + zr * 8192 + (kv ? C_VA : C_KA) + g * 256 + hd);
        if (ok) *(f32x4*)(p.out + oo + e) = (f32x4){bflo(wv[0]), bfhi(wv[0]), bflo(wv[1]), bfhi(wv[1])}; }
}

DI void phase_prefix(const Params& p) {
    copy_rows_all(p);
    const float* SLOC = (const float*)(p.ws + W_SLOC); const float* ASC = (const float*)(p.ws + W_ASC); float* SST = (float*)(p.ws + W_SSTART);
    const int tid = otid();
    for (int e = blockIdx.x * 512 + tid; e < 131072; e += gridDim.x * 512) { const int bh = e >> 14, idx = e & 16383, dk = idx >> 7; float s = 0.f;
        for (int s8 = 0; s8 < 4; ++s8) { float a[8], l[8];
#pragma unroll
            for (int j = 0; j < 8; ++j) { const int it = bh * 32 + s8 * 8 + j; a[j] = ASC[it * 128 + dk]; l[j] = SLOC[(size_t)it * 16384 + idx]; }
#pragma unroll
            for (int j = 0; j < 8; ++j) { const int it = bh * 32 + s8 * 8 + j; SST[(size_t)it * 16384 + idx] = s; s = a[j] * s + l[j]; } }
        p.out[O_HGP + e] = s; }
}
DI void attn_compute_win(const Params& p, char* smem, const AttnItem& a, const bf16x8 qf0, const bf16x8 qf1) {
    const int tid = otid(), w = tid >> 6, lane = tid & 63, l15 = lane & 15, g4 = lane >> 4;
    const u16* Ks = (const u16*)smem; const unsigned* VT = (const unsigned*)(smem + 36864);
    const int nb = a.nb, h = a.h, grp = a.grp;
    const int qi = 16 * w + l15; const size_t qrow = attn_qrow(a, qi);
    const u16* kbase = Ks + (w * 16 + l15) * 72 + g4 * 8;
    f32x4 s[9];
#pragma unroll
    for (int kg = 0; kg < 3; ++kg) { bf16x8 ka[4][2];
#pragma unroll
        for (int i = 0; i < 4; ++i) if (kg * 4 + i < 9) { const u16* kp_ = kbase + (kg * 4 + i) * 16 * 72; ka[i][0] = *(const bf16x8*)kp_; ka[i][1] = *(const bf16x8*)(kp_ + 32); }
        __builtin_amdgcn_sched_barrier(0);
#pragma unroll
        for (int i = 0; i < 4; ++i) if (kg * 4 + i < 9) { f32x4 acc = {0.f, 0.f, 0.f, 0.f}; acc = MFMA16(ka[i][0], qf0, acc); acc = MFMA16(ka[i][1], qf1, acc); s[kg * 4 + i] = acc; }
        __builtin_amdgcn_sched_barrier(0); }
    const float c1 = 0.125f * 1.4426950408889634f;
    float mx = -1e30f;
#pragma unroll
    for (int i = 0; i < 9; ++i) { const float bound = (i == 8 || (w + i) >= 8 || nb > 0) ? 3.0e38f : -1e30f;
#pragma unroll
        for (int j = 0; j < 4; ++j) { float v = fminf(s[i][j] * c1, bound);
            if (i == 0) v = (4 * g4 + j >= l15) ? v : -1e30f;
            if (i == 8) v = (4 * g4 + j <= l15) ? v : -1e30f;
            s[i][j] = v; mx = fmaxf(mx, v); } }
    mx = fmaxf(mx, __shfl_xor(mx, 16)); mx = fmaxf(mx, __shfl_xor(mx, 32));
    float l = 0.f;
#pragma unroll
    for (int i = 0; i < 9; ++i)
#pragma unroll
        for (int j = 0; j < 4; ++j) { const float e = __builtin_amdgcn_exp2f(s[i][j] - mx); s[i][j] = e; l += e; }
    l += __shfl_xor(l, 16); l += __shfl_xor(l, 32);
    f32x4 o[4];
#pragma unroll
    for (int db = 0; db < 4; ++db) o[db] = (f32x4){0.f, 0.f, 0.f, 0.f};
    const f32x4 zz = {0.f, 0.f, 0.f, 0.f};
#pragma unroll
    for (int j2 = 0; j2 < 5; ++j2) { unsigned vr[4][4];
#pragma unroll
        for (int db = 0; db < 4; ++db) { const unsigned* vp = VT + (db * 16 + l15) * 129 + 8 * (w + 2 * j2) + 2 * g4; vr[db][0] = vp[0]; vr[db][1] = vp[1];
            if (j2 < 4) { vr[db][2] = vp[8]; vr[db][3] = vp[9]; } else { vr[db][2] = vr[db][0]; vr[db][3] = vr[db][1]; } }
        const bf16x8 pf = j2 < 4 ? pack8(s[2 * j2], s[2 * j2 + 1]) : pack8(s[8], zz);
        __builtin_amdgcn_sched_barrier(0);
#pragma unroll
        for (int db = 0; db < 4; ++db) o[db] = MFMA16(mk8(vr[db][0], vr[db][1], vr[db][2], vr[db][3]), pf, o[db]);
        __builtin_amdgcn_sched_barrier(0); }
    const float inv = 1.0f / l;
    u16* OA = (u16*)(p.ws + W_OA); float* LSE = (float*)(p.ws + W_LSE); const size_t ro = (size_t)grp * NTOK + qrow;
#pragma unroll
    for (int db = 0; db < 4; ++db) { u32x2 wv = {pk2(o[db][0] * inv, o[db][1] * inv), pk2(o[db][2] * inv, o[db][3] * inv)};
        *(u32x2*)(OA + ro * 256 + h * 64 + db * 16 + 4 * g4) = wv; }
    if (g4 == 0) LSE[ro * 4 + h] = mx * 0.6931471805599453f + __logf(l);
}
constexpr int P2_HGL = 256, P2_AT = P2_HGL + 2048, P2_DA = P2_AT + 640, P2_HS = P2_DA + 512, P2_CP = P2_HS;
DI void phase_mix(const Params& p, char* smem, int sub) {
    const int G = (int)gridDim.x;
    if (sub == 31) { unsigned* cm = (unsigned*)(p.ws + W_CNT) + 64 * 65; const int q0 = (int)blockIdx.x - (G >= 192 ? 128 : 0);
        for (int q = q0; q >= 0 && q < 64; q += G) { const int rg = q >> 4, cb = q & 15;
            skinny_tile(p, 1, (const u16*)(p.ws + W_HM) + (size_t)rg * 128 * 1024, (const u16*)(p.ws + W_WMEMT), rg * 128, cb * 32); wg_publish(cm); } }
    int it = blockIdx.x;
    for (; it < P2_HGL; it += G) if (sub & 1) hg_local(p, smem, it);
    if (sub == 31) wg_consume((unsigned*)(p.ws + W_CNT) + 64 * 65, 64u);
    if (!(sub & 2)) { while (it < P2_AT) it += G; }
    if (it < P2_AT) {
        AttnRegs R; AttnItem a = attn_decode(it - P2_HGL); attn_load(p, a, R);
        for (;;) {
            attn_stage(smem, R); const bf16x8 q0 = R.q0, q1 = R.q1;
            __syncthreads();
            const int nx = it + G; const bool more = nx < P2_AT; AttnItem an = a;
            if (more) { an = attn_decode(nx - P2_HGL); attn_load(p, an, R); }
            if (a.is_mem) attn_compute(p, smem, a, q0, q1); else attn_compute_win(p, smem, a, q0, q1);
            __syncthreads();
            it = nx; a = an;
            if (!more) break;
        }
    }
    for (; it < P2_CP; it += G) {
        if (it < P2_DA) { if (sub & 4) dec_attn(p, smem, it - P2_AT); }
        else if (it < P2_HS) { if (sub & 8) hg_step(p, smem, it - P2_DA); }
    }
    if (sub == 31) {
        if (threadIdx.x == 0) { unsigned* cnt = (unsigned*)(p.ws + W_BAR); unsigned sp = 0;
            while (__hip_atomic_load(cnt, __ATOMIC_RELAXED, __HIP_MEMORY_SCOPE_AGENT) < (unsigned)P2_HGL) { __builtin_amdgcn_s_sleep(2); if (++sp > (1u << 20)) break; }
            __builtin_amdgcn_fence(__ATOMIC_ACQUIRE, "agent"); asm volatile("s_waitcnt vmcnt(0)" ::: "memory"); }
        __syncthreads();
        phase_prefix(p);
    }
}

DI void phase_hgout(const Params& p, char* smem) {
    for (int it = blockIdx.x; it < 256; it += gridDim.x) hg_out(p, smem, it);
    const u16* Z = (const u16*)(p.ws + W_Z); const u16* OA = (const u16*)(p.ws + W_OA); const float* LSE = (const float*)(p.ws + W_LSE); u16* UA = (u16*)(p.ws + W_UA);
    const int tid = otid();
    for (size_t q = (size_t)blockIdx.x * 512 + tid; q < (size_t)NTOK * 32; q += (size_t)gridDim.x * 512) { const size_t tok = q >> 5; const int c8 = (int)(q & 31) * 8, h = c8 >> 6;
        const float l0 = LSE[(0 * (size_t)NTOK + tok) * 4 + h], l1 = LSE[(1 * (size_t)NTOK + tok) * 4 + h], l2 = LSE[(2 * (size_t)NTOK + tok) * 4 + h];
        const float m = fmaxf(l0, fmaxf(l1, l2)); float w0 = __expf(l0 - m), w1 = __expf(l1 - m), w2 = __expf(l2 - m); const float inv = 1.0f / (w0 + w1 + w2); w0 *= inv; w1 *= inv; w2 *= inv;
        const u32x4 a = *(const u32x4*)(OA + (0 * (size_t)NTOK + tok) * 256 + c8), bq = *(const u32x4*)(OA + (1 * (size_t)NTOK + tok) * 256 + c8), c = *(const u32x4*)(OA + (2 * (size_t)NTOK + tok) * 256 + c8);
        const u32x4 gz = *(const u32x4*)(Z + tok * 8192 + C_GA + c8); u32x4 r;
#pragma unroll
        for (int j = 0; j < 4; ++j) { const float lo = (w0 * bflo(a[j]) + w1 * bflo(bq[j]) + w2 * bflo(c[j])) * siluf_(bflo(gz[j])), hi = (w0 * bfhi(a[j]) + w1 * bfhi(bq[j]) + w2 * bfhi(c[j])) * siluf_(bfhi(gz[j])); r[j] = pk2(lo, hi); }
        *(u32x4*)(UA + tok * 1024 + c8) = r; }
}
DI void phase_final(const Params& p) {
    const float* rss = (const float*)(p.ws + W_ROWSS); const u16* XN = (const u16*)(p.ws + W_MACC);
    const int tid = otid(); const size_t tot = (size_t)NTOK * 128, gs = (size_t)gridDim.x * 512;
    for (size_t q0 = (size_t)blockIdx.x * 512 + tid; q0 < tot; q0 += 4 * gs) { u32x4 v[4]; float4 g0[4], g1[4]; float rs[4];
#pragma unroll
        for (int j = 0; j < 4; ++j) { size_t q = q0 + j * gs; if (q >= tot) q = q0; const size_t row = q >> 7; const int c8 = (int)(q & 127) * 8;
            rs[j] = rss[row]; g0[j] = *(const float4*)(p.norm_final + c8); g1[j] = *(const float4*)(p.norm_final + c8 + 4); v[j] = *(const u32x4*)(XN + row * 1024 + c8); }
#pragma unroll
        for (int j = 0; j < 4; ++j) { const size_t q = q0 + j * gs; if (q < tot) { const size_t row = q >> 7; const int c8 = (int)(q & 127) * 8; const float r = rsqrtf(rs[j] * (1.0f / 1024.0f) + EPSN);
            float4 o0 = {bflo(v[j][0]) * r * g0[j].x, bfhi(v[j][0]) * r * g0[j].y, bflo(v[j][1]) * r * g0[j].z, bfhi(v[j][1]) * r * g0[j].w};
            float4 o1 = {bflo(v[j][2]) * r * g1[j].x, bfhi(v[j][2]) * r * g1[j].y, bflo(v[j][3]) * r * g1[j].z, bfhi(v[j][3]) * r * g1[j].w};
            *(float4*)(p.out + row * 1024 + c8) = o0; *(float4*)(p.out + row * 1024 + c8 + 4) = o1; } } }
}

#ifndef PHMASK
#define PHMASK 0xff
#endif
template <bool COOP>
__global__ __launch_bounds__(512, 2) void mega(Params p, int lo, int hi) {
    extern __shared__ __attribute__((aligned(16))) unsigned char shm[];
    char* smem = (char*)shm;
    PG8_LAS unsigned char* lds = (PG8_LAS unsigned char*)shm;
    const int G = (int)gridDim.x, c = (int)blockIdx.x;
#ifndef P2SUB
#define P2SUB 31
#endif
#ifndef XSYNC
#define XSYNC 0
#endif
#ifndef REP_MASK
#define REP_MASK 0
#endif
    XcdBarrier xb;
    if (COOP) {
        volatile PG8_LAS unsigned* st = (volatile PG8_LAS unsigned*)(lds + 131072);
        if (threadIdx.x == 0) { st[0] = 0u; st[1] = 0u; }
        __syncthreads();
        xb = xcd_barrier_post((unsigned*)(p.ws + W_BAR), st);
        if (lo < 0) cg::this_grid().sync();
        for (int i = 0; i < XSYNC; ++i) xcd_barrier(xb);
    }
    bool first = true;
    for (int pp = 2 * lo; pp < 2 * hi; ++pp) {
        const int ph = pp >> 1;
        if ((pp & 1) && !((REP_MASK >> ph) & 1)) continue;
        if (COOP && ph == 3) continue;
        if (COOP && ph == 7) continue;
        if (COOP && !first) xcd_barrier(xb);
        first = false;
        if (ph == 1 || ph == 5 || ph == 6) {
            GDesc d0, d1, d2, d3; MSched S; S.nsub = 1; S.has_extra = 0; S.ex_pm = 0; S.ex_pn = 0; S.ex_gi = 0;
            if (ph == 1) { d0 = GDesc{(const u16*)(p.ws + W_H), (const u16*)(p.ws + W_WINT), 1024, 0}; d1 = d0; d2 = d0; d3 = d0; S.so.init(NTOK_P, C_ZG, G, c); }
            else if (ph == 5) { const u16* H = (const u16*)(p.ws + W_H); const u16* WG = (const u16*)(p.ws + W_WINT) + (size_t)C_ZG * 1024;
                d0 = GDesc{H, WG, 1024, 7}; d1 = GDesc{H, WG + (size_t)1024 * 1024, 1024, 7}; d2 = GDesc{H, WG + (size_t)2048 * 1024, 1024, 7};
                d3 = GDesc{(const u16*)(p.ws + W_UA), (const u16*)(p.ws + W_WAT), 1024, 6}; S.so.init(NTOK_P, 1024, G, c); S.nsub = 4; }
            else { d0 = GDesc{(const u16*)(p.ws + W_MERGED), (const u16*)(p.ws + W_WOUTT), 1024, 5}; d1 = d0; d2 = d0; d3 = d0; S.so.init(NTOK_P, 1024, G, c); }
            S.nreg = c < S.so.nwg ? (S.so.nwg - c + G - 1) / G : 0;
            if (PHMASK & 2) { const size_t rsoff = (pp & 1) ? (W_SLOC - W_ROWSS) : 0; gemm_multi(lds, p, d0, d1, d2, d3, S, rsoff); phase_skinny(p, ph, rsoff); }
        }
        else if (ph == 0) { if (PHMASK & 1) phase_prep(p, smem); }
        else if (ph == 2) { if (PHMASK & 4) phase_mix(p, smem, (pp & 1) ? P2SUB : 31); }
        else if (ph == 3) { if (PHMASK & 8) phase_prefix(p); }
        else if (ph == 4) { if (PHMASK & 16) phase_hgout(p, smem); }
        else { if (PHMASK & 128) phase_final(p); }
    }
}

#ifndef MULTI_LAUNCH
#define MULTI_LAUNCH 0
#endif
extern "C" void kernel_launch(void* const* d_in, const int* in_sizes, int n_in, void* d_out, int out_size, void* d_ws, size_t ws_size, hipStream_t stream) {
    constexpr size_t kDynLds = 131072 + 16;
    static int grid_blocks = 0;
    if (!grid_blocks) {
        int dev = 0, cus = 0, per_cu = 0;
        hipGetDevice(&dev);
        hipDeviceGetAttribute(&cus, hipDeviceAttributeMultiprocessorCount, dev);
        hipFuncSetAttribute((const void*)mega<true>, hipFuncAttributeMaxDynamicSharedMemorySize, (int)kDynLds);
        hipFuncSetAttribute((const void*)mega<false>, hipFuncAttributeMaxDynamicSharedMemorySize, (int)kDynLds);
        hipOccupancyMaxActiveBlocksPerMultiprocessor(&per_cu, mega<true>, 512, kDynLds);
        if (per_cu < 1) per_cu = 1;
        if (per_cu > 1) per_cu = 1;
        grid_blocks = cus * per_cu;
        if (grid_blocks > 256) grid_blocks = 256;
    }
    Params p{};
    const float* const* in = (const float* const*)d_in;
    p.x_prompt = in[0]; p.x_sample = in[1]; p.mem_prompt = in[2]; p.c_w1 = in[3]; p.c_w2 = in[4]; p.c_w3 = in[5]; p.c_mem = in[6]; p.st_hgrn = in[7];
    p.norm_in = in[8]; p.w_in = in[9]; p.lb_logits = in[10]; p.norm_hgrn = in[11]; p.norm_mem = in[12]; p.w_mem_kv = in[13]; p.w_a = in[14]; p.w_b = in[15];
    p.w_m = in[16]; p.w_out = in[17]; p.norm_final = in[18];
    p.out = (float*)d_out; p.ws = (char*)d_ws;
#if MULTI_LAUNCH
    for (int ph = 0; ph < 8; ++ph) hipLaunchKernelGGL((mega<false>), dim3(grid_blocks), dim3(512), kDynLds, stream, p, ph, ph + 1);
#else
    int lo = 0, hi = 8;
    hipMemsetAsync((char*)d_ws + W_BAR, 0, BAR_ZERO_BYTES, stream);
    void* args[] = {&p, &lo, &hi};
    hipError_t e = hipLaunchCooperativeKernel((const void*)mega<true>, dim3(grid_blocks), dim3(512), args, kDynLds, stream);
    if (e != hipSuccess) fprintf(stderr, "cooperative launch failed: %s (grid %d)\n", hipGetErrorString(e), grid_blocks);
#endif
}
```

```cpp
#include <hip/hip_runtime.h>
#include <hip/hip_cooperative_groups.h>
#include <cstdio>
namespace cg = cooperative_groups;

#define DI __device__ __forceinline__
typedef unsigned short u16;
typedef float f2v __attribute__((ext_vector_type(2)));
typedef __bf16 b2v __attribute__((ext_vector_type(2)));
typedef short s16x4 __attribute__((ext_vector_type(4)));
typedef unsigned u32x2 __attribute__((ext_vector_type(2)));

DI unsigned pk2(float x, float y) { f2v v = {x, y}; b2v r = __builtin_convertvector(v, b2v); return __builtin_bit_cast(unsigned, r); }
DI u16 f2bf(float x) { __bf16 b = (__bf16)x; return __builtin_bit_cast(u16, b); }
DI float bf2f(u16 v) { return __uint_as_float(((unsigned)v) << 16); }
DI float bflo(unsigned w) { return __uint_as_float(w << 16); }
DI float bfhi(unsigned w) { return __uint_as_float(w & 0xffff0000u); }
DI float sigmoidf_(float x) { return __builtin_amdgcn_rcpf(1.0f + __expf(-x)); }
DI float siluf_(float x) { return x * __builtin_amdgcn_rcpf(1.0f + __expf(-x)); }

constexpr int DM = 1024, SEQ = 8192, NTOK_P = 16384, NTOK_S = 128, NTOK = 16512, MPAD = 16640, DIN = 8192;
constexpr int C_QA = 0, C_KA = 768, C_VA = 1536, C_GA = 2304, C_QB = 2560, C_FB = 3072, C_IB = 3584, C_GB = 4096, C_QM = 4608, C_GM = 4864, C_ZG = 5120;
constexpr float EPSN = 1e-6f;
constexpr size_t O_YP = 0, O_YS = 16777216, O_W1P = 16908288, O_W2P = 17039360, O_W3P = 17563648, O_MKV = 19660800, O_HGP = 19922944,
                 O_W1S = 20054016, O_W2S = 20119552, O_W3S = 20185088, O_HGS = 20250624;
constexpr size_t al256(size_t x) { return (x + 255) & ~(size_t)255; }
constexpr size_t W_H = 0;
constexpr size_t W_HM = W_H + al256((size_t)MPAD * 1024 * 2);
constexpr size_t W_WINT = W_HM + al256((size_t)512 * 1024 * 2);
constexpr size_t W_WMEMT = W_WINT + al256((size_t)8192 * 1024 * 2);
constexpr size_t W_WAT = W_WMEMT + al256((size_t)512 * 1024 * 2);
constexpr size_t W_WBT = W_WAT + al256((size_t)1024 * 1024 * 2);
constexpr size_t W_WMT = W_WBT + al256((size_t)1024 * 512 * 2);
constexpr size_t W_WOUTT = W_WMT + al256((size_t)1024 * 256 * 2);
constexpr size_t W_Z = W_WOUTT + al256((size_t)1024 * 1024 * 2);
constexpr size_t W_MEMKV = W_Z + al256((size_t)MPAD * 8192 * 2);
constexpr size_t W_OA = W_MEMKV + al256((size_t)512 * 512 * 2);
constexpr size_t W_LSE = W_OA + al256((size_t)3 * NTOK * 256 * 2);
constexpr size_t W_UA = W_LSE + al256((size_t)3 * NTOK * 4 * 4);
constexpr size_t W_UB = W_UA + al256((size_t)MPAD * 1024 * 2);
constexpr size_t W_UM = W_UB + al256((size_t)MPAD * 512 * 2);
constexpr size_t W_SLOC = W_UM + al256((size_t)MPAD * 256 * 2);
constexpr size_t W_ASC = W_SLOC + al256((size_t)256 * 16384 * 4);
constexpr size_t W_SSTART = W_ASC + al256((size_t)256 * 128 * 4);
constexpr size_t W_MACC = W_SSTART + al256((size_t)256 * 16384 * 4);
constexpr size_t W_MERGED = W_MACC + al256((size_t)MPAD * 1024 * 4);
constexpr size_t W_ROWSS = W_MERGED + al256((size_t)MPAD * 1024 * 2);
constexpr size_t W_BAR = W_ROWSS + al256((size_t)MPAD * 4);
constexpr size_t W_CNT = W_BAR + 16384;
constexpr size_t BAR_ZERO_BYTES = 16384 + 66 * 256;
constexpr size_t W_GSC = W_BAR + 36864;
constexpr size_t W_END = W_GSC + (size_t)256 * 3 * 131072;

struct Params {
    const float *x_prompt, *x_sample, *mem_prompt, *c_w1, *c_w2, *c_w3, *c_mem, *st_hgrn, *norm_in, *w_in, *lb_logits, *norm_hgrn, *norm_mem,
        *w_mem_kv, *w_a, *w_b, *w_m, *w_out, *norm_final;
    float* out;
    char* ws;
};

namespace pg8 {
#define PG8_LAS __attribute__((address_space(3)))
typedef unsigned short bf16_t;
typedef short bf16x8 __attribute__((ext_vector_type(8)));
typedef float f32x4 __attribute__((ext_vector_type(4)));
typedef unsigned u32x4 __attribute__((ext_vector_type(4)));
constexpr int BM = 256, BK = 64, HALF = 128, HTB = HALF * BK * 2  , STAGE_BYTES = 8 * HTB, NXCD = 8, WGM = 8;

__host__ __device__ __forceinline__ int lds_byte(int r, int c) { const int st = (r >> 4) * 2 + (c >> 5), rr = r & 15, cc = c & 31, ob = rr * 64 + cc * 2; return st * 1024 + (ob ^ (((ob >> 9) & 1) << 5)); }
__host__ __device__ __forceinline__ void stage_rc(int b, int& R, int& C) { const int st = b / 1024, sb = b % 1024, swz = sb ^ (((sb >> 9) & 1) << 5); R = (st >> 1) * 16 + swz / 64; C = (st & 1) * 32 + (swz % 64) / 2; }
__host__ __device__ __forceinline__ int perm32(int rho) { const int n = rho >> 4, i = rho & 15; return 8 * (i >> 2) + 4 * n + (i & 3); }

struct Unit { int pm, pn; };
struct Gemm { const bf16_t* A; const bf16_t* Bt; int M, N, K; };

struct StaticOrder {
    int nM, nN, nwg, G, c;
    __host__ __device__ void init(int M, int N, int G_, int c_) { nM = M / BM; nN = N / BM; nwg = nM * nN; G = G_; c = c_; }
    __host__ __device__ bool next(int i, Unit& u) const {
        const long L = (long)i * G + c; if (L >= nwg) return false;
        int wgid = (int)L; { const int q = nwg / NXCD, r = nwg % NXCD, xcd = wgid % NXCD, off = wgid / NXCD; wgid = (xcd < r ? xcd * (q + 1) : r * (q + 1) + (xcd - r) * q) + off; }
        const int nig = WGM * nN, gid = wgid / nig, fm = gid * WGM, gsz = (nM - fm) < WGM ? (nM - fm) : WGM;
        u.pm = fm + ((wgid % nig) % gsz); u.pn = (wgid % nig) / gsz; return true;
    }
    __device__ __forceinline__ void a_ready(const Unit&) const {}
    __device__ __forceinline__ void done(const Unit&) const {}
};
__device__ __forceinline__ unsigned cvt_pk_bf16(float lo, float hi) { unsigned r; asm volatile("v_cvt_pk_bf16_f32 %0, %1, %2" : "=v"(r) : "v"(lo), "v"(hi)); return r; }
template <class Epi, class Sched, bool STAMP = false>
__device__ __forceinline__ void gemm_phase(PG8_LAS unsigned char* lds, const Gemm g, const Sched& S, const Epi& E, unsigned long long* stamps) {
    const int tid = threadIdx.x, wid = __builtin_amdgcn_readfirstlane(tid >> 6), lane = tid & 63, wr = wid >> 2, wc = wid & 3, fr = lane & 15, fq = lane >> 4;
    const int K = g.K, nt = K / BK;
    int ts_lo = 0, ts_hi = 0, nts = 0; const unsigned long long rt_entry = STAMP ? (unsigned long long)wall_clock64() : 0ull;
#define PG8_STAMP() do { if (STAMP && wid == 0 && nts < 64) { const unsigned long long _c = (unsigned long long)clock64(); \
        ts_lo = (lane == nts) ? (int)(unsigned)_c : ts_lo; ts_hi = (lane == nts) ? (int)(unsigned)(_c >> 32) : ts_hi; ++nts; } } while (0)
    PG8_STAMP();
    unsigned voffA[2], voffB[2];
#pragma unroll
    for (int i = 0; i < 2; ++i) { int R, C; stage_rc(tid * 16 + i * 8192, R, C); const int Rb = Epi::PERM ? ((R & ~31) + perm32(R & 31)) : R;
        voffA[i] = (unsigned)(R * K + C) * 2u; voffB[i] = (unsigned)(Rb * K + C) * 2u; }
    const size_t kstep = (size_t)(BK * 2);
    const size_t hstep = (size_t)HALF * K * 2;
    const size_t tstep = 2 * hstep;
    const unsigned ldsw = (unsigned)wid * 1024u;
    const int aoff = lds_byte(wr * 64 + fr, fq * 8), boff = lds_byte(wc * 32 + fr, fq * 8);
#define PG8_SA(b, h) (((b) * 2 + (h)) * HTB)
#define PG8_SB(b, h) ((4 + (b) * 2 + (h)) * HTB)
#define PG8_STAGE(bufoff, gbase, voff) do { _Pragma("unroll") for (int _i = 0; _i < 2; ++_i) \
        __builtin_amdgcn_global_load_lds((const unsigned*)((const char*)(gbase) + (voff)[_i]), (PG8_LAS unsigned*)(lds + (bufoff) + ldsw + _i * 8192), 16, 0, 0); } while (0)
#define PG8_LDA(dst, b, h) do { _Pragma("unroll") for (int m = 0; m < 4; ++m) _Pragma("unroll") for (int k = 0; k < 2; ++k) dst[m][k] = *(const PG8_LAS bf16x8*)(lds + PG8_SA(b, h) + aoff + m * 2048 + k * 1024); } while (0)
#define PG8_LDB(dst, b, h) do { _Pragma("unroll") for (int n = 0; n < 2; ++n) _Pragma("unroll") for (int k = 0; k < 2; ++k) dst[n][k] = *(const PG8_LAS bf16x8*)(lds + PG8_SB(b, h) + boff + n * 2048 + k * 1024); } while (0)
#define PG8_MMA(ai, bj, At, Bt) do { __builtin_amdgcn_s_setprio(1); _Pragma("unroll") for (int m = 0; m < 4; ++m) _Pragma("unroll") for (int n = 0; n < 2; ++n) _Pragma("unroll") for (int k = 0; k < 2; ++k) \
        acc[ai][bj][m][n] = __builtin_amdgcn_mfma_f32_16x16x32_bf16(Bt[n][k], At[m][k], acc[ai][bj][m][n], 0, 0, 0); __builtin_amdgcn_s_setprio(0); } while (0)
#define PG8_WAIT_V(n) asm volatile("s_waitcnt vmcnt(" #n ")" ::: "memory")
#define PG8_WAIT_L(n) asm volatile("s_waitcnt lgkmcnt(" #n ")" ::: "memory")
#define PG8_BAR __builtin_amdgcn_s_barrier()
#define PG8_SCHED __builtin_amdgcn_sched_barrier(0)
    Unit cur, nxt; int ui = 0;
    if (!S.next(0, cur)) return;
    f32x4 acc[2][2][4][2];
#pragma unroll
    for (int a = 0; a < 2; ++a)
#pragma unroll
        for (int b = 0; b < 2; ++b)
#pragma unroll
            for (int m = 0; m < 4; ++m)
#pragma unroll
                for (int n = 0; n < 2; ++n) acc[a][b][m][n] = (f32x4){0.f, 0.f, 0.f, 0.f};
    bf16x8 At[4][2], B0[2][2], B1[2][2];
    const char* cA = (const char*)g.A + (size_t)cur.pm * tstep; const char* cB = (const char*)g.Bt + (size_t)cur.pn * tstep;
    S.a_ready(cur);
    PG8_STAGE(PG8_SB(0, 0), cB, voffB); PG8_STAGE(PG8_SA(0, 0), cA, voffA); PG8_STAGE(PG8_SB(0, 1), cB + hstep, voffB); PG8_STAGE(PG8_SA(0, 1), cA + hstep, voffA);
    if (wr == 1) PG8_BAR;
    PG8_WAIT_V(4); PG8_BAR;
    PG8_STAGE(PG8_SB(1, 0), cB + kstep, voffB); PG8_STAGE(PG8_SA(1, 0), cA + kstep, voffA); PG8_STAGE(PG8_SB(1, 1), cB + hstep + kstep, voffB);
    PG8_WAIT_V(6); PG8_BAR;
    PG8_STAMP();
    for (;;) {
        const bool has_next = S.next(ui + 1, nxt);
        const char* nA = has_next ? (const char*)g.A + (size_t)nxt.pm * tstep : cA; const char* nB = has_next ? (const char*)g.Bt + (size_t)nxt.pn * tstep : cB;
        for (int t = 0; t < nt; t += 2) {
            const bool last = (t == nt - 2);
            const char* a1 = cA + (size_t)(t + 1) * kstep;
            const char* a2 = last ? nA : cA + (size_t)(t + 2) * kstep; const char* b2 = last ? nB : cB + (size_t)(t + 2) * kstep;
            const char* a3 = a2 + kstep; const char* b3 = b2 + kstep;
            if (last && has_next) S.a_ready(nxt);
            PG8_LDB(B0, 0, 0); PG8_SCHED; PG8_LDA(At, 0, 0); PG8_STAGE(PG8_SA(1, 1), a1 + hstep, voffA);
            PG8_WAIT_L(8); PG8_BAR; PG8_WAIT_L(0); PG8_MMA(0, 0, At, B0); PG8_BAR; PG8_SCHED;
            PG8_LDB(B1, 0, 1); PG8_STAGE(PG8_SB(0, 0), b2, voffB);
            PG8_BAR; PG8_WAIT_L(0); PG8_MMA(0, 1, At, B1); PG8_BAR;
            PG8_LDA(At, 0, 1); PG8_STAGE(PG8_SA(0, 0), a2, voffA);
            PG8_BAR; PG8_WAIT_L(0); PG8_MMA(1, 0, At, B0); PG8_BAR; PG8_SCHED;
            PG8_STAGE(PG8_SB(0, 1), b2 + hstep, voffB);
            PG8_WAIT_V(6); PG8_BAR; PG8_MMA(1, 1, At, B1); PG8_BAR;
            PG8_LDB(B0, 1, 0); PG8_SCHED; PG8_LDA(At, 1, 0); PG8_STAGE(PG8_SA(0, 1), a2 + hstep, voffA);
            PG8_WAIT_L(8); PG8_BAR; PG8_WAIT_L(0); PG8_MMA(0, 0, At, B0); PG8_BAR; PG8_SCHED;
            PG8_LDB(B1, 1, 1); PG8_STAGE(PG8_SB(1, 0), b3, voffB);
            PG8_BAR; PG8_WAIT_L(0); PG8_MMA(0, 1, At, B1); PG8_BAR;
            PG8_LDA(At, 1, 1); PG8_STAGE(PG8_SA(1, 0), a3, voffA);
            PG8_BAR; PG8_WAIT_L(0); PG8_MMA(1, 0, At, B0); PG8_BAR; PG8_SCHED;
            PG8_STAGE(PG8_SB(1, 1), b3 + hstep, voffB);
            PG8_WAIT_V(6); PG8_BAR; PG8_MMA(1, 1, At, B1); PG8_BAR;
        }
        PG8_STAMP();
        if constexpr (!Epi::AFTER_DRAIN) { E(acc, cur, wr, wc, fr, fq); S.done(cur); }
        PG8_STAMP();
        if (!has_next) break;
#pragma unroll
        for (int a = 0; a < 2; ++a)
#pragma unroll
            for (int b = 0; b < 2; ++b)
#pragma unroll
                for (int m = 0; m < 4; ++m)
#pragma unroll
                    for (int n = 0; n < 2; ++n) acc[a][b][m][n] = (f32x4){0.f, 0.f, 0.f, 0.f};
        cur = nxt; cA = nA; cB = nB; ++ui;
    }
    PG8_WAIT_V(0);
    if (wr == 0) PG8_BAR;
    PG8_BAR;
    if constexpr (Epi::AFTER_DRAIN) { E.fused(acc, cur, wr, wc, fr, fq, lds, wid, lane); S.done(cur); }
    PG8_STAMP();
    if (STAMP && wid == 0) { stamps[lane] = lane < nts ? (((unsigned long long)(unsigned)ts_hi << 32) | (unsigned)ts_lo) : 0ull;
        if (lane == 62) stamps[62] = rt_entry; if (lane == 63) stamps[63] = (unsigned long long)wall_clock64(); }
#undef PG8_STAMP
#undef PG8_SA
#undef PG8_SB
#undef PG8_STAGE
#undef PG8_LDA
#undef PG8_LDB
#undef PG8_MMA
#undef PG8_WAIT_V
#undef PG8_WAIT_L
#undef PG8_BAR
#undef PG8_SCHED
}
}
#define XB_TMO      128
#define XB_XCNT(j)  (256  + 64 * (j))
#define XB_XSUB(j)  (1280 + 64 * (j))
#define XB_XGEN(j)  (2304 + 64 * (j))
#define XB_TOP      3328
#define XB_TOPGEN   3392
#define XCD_BAR_WORDS 3456
#define XB_SPIN_CAP (1u << 18)

__device__ __forceinline__ unsigned xb_ld(unsigned* p)              { return __hip_atomic_load(p, __ATOMIC_RELAXED, __HIP_MEMORY_SCOPE_AGENT); }
__device__ __forceinline__ unsigned xb_add(unsigned* p, unsigned v) { return __hip_atomic_fetch_add(p, v, __ATOMIC_RELAXED, __HIP_MEMORY_SCOPE_AGENT); }
__device__ __forceinline__ unsigned xb_xcc_id() { return (unsigned)__builtin_amdgcn_s_getreg((3 << 11) | 20) & 0xFu; }
#define XB_SPIN(cond, bar) do { unsigned _sp = 0; while (cond) { __builtin_amdgcn_s_sleep(1); \
    if ((++_sp & 255u) == 0u) { if (xb_ld(&(bar)[XB_TMO])) break; if (_sp > XB_SPIN_CAP) { atomicAdd(&(bar)[XB_TMO], 1u); break; } } } } while (0)

struct XcdBarrier {
    unsigned* bar; unsigned x;
    volatile PG8_LAS unsigned* st;
};

__device__ __forceinline__ XcdBarrier xcd_barrier_post(unsigned* bar, volatile PG8_LAS unsigned* st) {
    XcdBarrier b; b.bar = bar; b.x = xb_xcc_id(); b.st = st;
    if (threadIdx.x == 0) (void)xb_add(&bar[XB_XCNT(b.x)], 1u);
    return b;
}
__device__ __forceinline__ void xcd_barrier_complete(unsigned* bar, unsigned x, unsigned& nloc, unsigned& nx) {
    const unsigned G = gridDim.x * gridDim.y * gridDim.z;
    unsigned sum, cnt, mine, sp = 0u;
    for (;;) {
        sum = 0u; cnt = 0u; mine = 0u;
#pragma unroll
        for (unsigned j = 0; j < 16; ++j) { const unsigned c = xb_ld(&bar[XB_XCNT(j)]); sum += c; cnt += (c > 0u) ? 1u : 0u; mine = (j == x) ? c : mine; }
        if (sum == G) break;
        __builtin_amdgcn_s_sleep(1);
        if ((++sp & 255u) == 0u) { if (xb_ld(&bar[XB_TMO])) break; if (sp > XB_SPIN_CAP) { atomicAdd(&bar[XB_TMO], 1u); break; } }
    }
    nloc = mine > 0u ? mine : 1u; nx = cnt > 0u ? cnt : 1u;
}

__device__ __forceinline__ void xcd_barrier(const XcdBarrier& b) {
    asm volatile("s_waitcnt vmcnt(0)" ::: "memory");
    __syncthreads();
    if (threadIdx.x == 0) {
        unsigned* bar = b.bar;
        __builtin_amdgcn_s_waitcnt(0);
        unsigned nloc = b.st[0], nx = b.st[1];
        if (nloc == 0u) { xcd_barrier_complete(bar, b.x, nloc, nx); b.st[0] = nloc; b.st[1] = nx; }
        const unsigned old = xb_add(&bar[XB_XSUB(b.x)], 1u);
        const unsigned gen = old / nloc;
        if (old + 1u == (gen + 1u) * nloc) {
            __builtin_amdgcn_fence(__ATOMIC_RELEASE, "agent");
            asm volatile("s_waitcnt vmcnt(0)" ::: "memory");
            const unsigned og = xb_add(&bar[XB_TOP], 1u);
            const unsigned tg = og / nx;
            if (og + 1u == (tg + 1u) * nx) xb_add(&bar[XB_TOPGEN], 1u);
            else XB_SPIN(xb_ld(&bar[XB_TOPGEN]) == tg, bar);
            __builtin_amdgcn_fence(__ATOMIC_ACQUIRE, "agent");
            xb_add(&bar[XB_XGEN(b.x)], 1u);
            asm volatile("s_waitcnt vmcnt(0)" ::: "memory");
        } else {
            XB_SPIN(xb_ld(&bar[XB_XGEN(b.x)]) == gen, bar);
            __builtin_amdgcn_fence(__ATOMIC_ACQUIRE, "agent");
            asm volatile("s_waitcnt vmcnt(0)" ::: "memory");
        }
    }
    __syncthreads();
}

using pg8::bf16x8; using pg8::f32x4; using pg8::u32x4;
#define MFMA16(a, b, c) __builtin_amdgcn_mfma_f32_16x16x32_bf16((a), (b), (c), 0, 0, 0)
DI int otid() { int t = threadIdx.x; asm volatile("" : "+v"(t)); return t; }
DI float wave_sum(float v) { for (int o = 32; o >= 1; o >>= 1) v += __shfl_xor(v, o); return v; }
DI float wave_max(float v) { for (int o = 32; o >= 1; o >>= 1) v = fmaxf(v, __shfl_xor(v, o)); return v; }
DI bf16x8 mk8(unsigned a, unsigned b, unsigned c, unsigned d) { u32x4 w = {a, b, c, d}; return __builtin_bit_cast(bf16x8, w); }
DI bf16x8 pack8(const f32x4& a, const f32x4& b) { return mk8(pk2(a[0], a[1]), pk2(a[2], a[3]), pk2(b[0], b[1]), pk2(b[2], b[3])); }

DI void norm_row(const float* src, const float* gain, u16* dst, int lane) {
    float4 v[4]; float ss = 0.f;
#pragma unroll
    for (int i = 0; i < 4; ++i) { v[i] = ((const float4*)src)[lane + 64 * i]; ss += v[i].x * v[i].x + v[i].y * v[i].y + v[i].z * v[i].z + v[i].w * v[i].w; }
    ss = wave_sum(ss);
    const float rs = rsqrtf(ss * (1.0f / 1024.0f) + EPSN);
#pragma unroll
    for (int i = 0; i < 4; ++i) { const float4 g = ((const float4*)gain)[lane + 64 * i];
        u32x2 w = {pk2(v[i].x * rs * g.x, v[i].y * rs * g.y), pk2(v[i].z * rs * g.z, v[i].w * rs * g.w)};
        *(u32x2*)(dst + (size_t)(lane + 64 * i) * 4) = w; }
}
struct TJob { const float* src; u16* dst; int K, N, tk, tn, ldk, koff; };
DI TJob tjob(const Params& p, int j) {
    TJob t;
    if (j < 2048) t = TJob{p.w_in, (u16*)(p.ws + W_WINT), 1024, 8192, j & 15, j >> 4, 1024, 0};
    else if (j < 2176) { const int q = j - 2048; t = TJob{p.w_mem_kv, (u16*)(p.ws + W_WMEMT), 1024, 512, q & 15, q >> 4, 1024, 0}; }
    else if (j < 2240) { const int q = j - 2176; t = TJob{p.w_a, (u16*)(p.ws + W_WAT), 256, 1024, q & 3, q >> 2, 1024, 0}; }
    else if (j < 2368) { const int q = j - 2240; t = TJob{p.w_b, (u16*)(p.ws + W_WAT), 512, 1024, q & 7, q >> 3, 1024, 256}; }
    else if (j < 2432) { const int q = j - 2368; t = TJob{p.w_m, (u16*)(p.ws + W_WAT), 256, 1024, q & 3, q >> 2, 1024, 768}; }
    else { const int q = j - 2432; t = TJob{p.w_out, (u16*)(p.ws + W_WOUTT), 1024, 1024, q & 15, q >> 4, 1024, 0}; }
    return t;
}
DI void tload(const TJob& t, int tid, float4 (&v)[2]) {
    const int r = tid >> 4, c4 = (tid & 15) * 4;
#pragma unroll
    for (int it = 0; it < 2; ++it) v[it] = *(const float4*)(t.src + (size_t)(t.tk * 64 + r + 32 * it) * t.N + t.tn * 64 + c4);
}
DI void phase_prep(const Params& p, char* smem) {
    const int tid = otid(), wid = tid >> 6, lane = tid & 63;
    u16* H = (u16*)(p.ws + W_H); u16* HM = (u16*)(p.ws + W_HM);
    float* t = (float*)smem;
    { int j = blockIdx.x; const int G = gridDim.x;
      if (j < 2688) { TJob cur = tjob(p, j); float4 v[2]; tload(cur, tid, v);
        for (;;) {
            { const int r = tid >> 4, c4 = (tid & 15) * 4;
#pragma unroll
              for (int it = 0; it < 2; ++it) { float* d = t + (r + 32 * it) * 65 + c4; d[0] = v[it].x; d[1] = v[it].y; d[2] = v[it].z; d[3] = v[it].w; } }
            __syncthreads();
            const int jn = j + G; const bool more = jn < 2688; TJob nx = cur;
            if (more) { nx = tjob(p, jn); tload(nx, tid, v); }
            { const int n = tid >> 3, ks = (tid & 7) * 8; float a[8];
#pragma unroll
              for (int i = 0; i < 8; ++i) a[i] = t[(ks + i) * 65 + n];
              u32x4 w = {pk2(a[0], a[1]), pk2(a[2], a[3]), pk2(a[4], a[5]), pk2(a[6], a[7])};
              *(u32x4*)(cur.dst + (size_t)(cur.tn * 64 + n) * cur.ldk + cur.koff + cur.tk * 64 + ks) = w; }
            __syncthreads();
            if (!more) break;
            j = jn; cur = nx;
        } } }
    { const int nw = gridDim.x * 8;
      for (int r = blockIdx.x * 8 + wid; r < NTOK + 512; r += 2 * nw) {
        const int r2 = r + nw; const bool two = r2 < NTOK + 512;
        const float* s0; const float* g0; u16* d0; const float* s1; const float* g1; u16* d1;
        if (r < NTOK_P) { s0 = p.x_prompt + (size_t)r * 1024; g0 = p.norm_in; d0 = H + (size_t)r * 1024; }
        else if (r < NTOK) { s0 = p.x_sample + (size_t)(r - NTOK_P) * 1024; g0 = p.norm_in; d0 = H + (size_t)r * 1024; }
        else { s0 = p.mem_prompt + (size_t)(r - NTOK) * 1024; g0 = p.norm_mem; d0 = HM + (size_t)(r - NTOK) * 1024; }
        const int rr = two ? r2 : r;
        if (rr < NTOK_P) { s1 = p.x_prompt + (size_t)rr * 1024; g1 = p.norm_in; d1 = H + (size_t)rr * 1024; }
        else if (rr < NTOK) { s1 = p.x_sample + (size_t)(rr - NTOK_P) * 1024; g1 = p.norm_in; d1 = H + (size_t)rr * 1024; }
        else { s1 = p.mem_prompt + (size_t)(rr - NTOK) * 1024; g1 = p.norm_mem; d1 = HM + (size_t)(rr - NTOK) * 1024; }
        float4 va[4], vb[4]; float sa = 0.f, sb = 0.f;
#pragma unroll
        for (int i = 0; i < 4; ++i) { va[i] = ((const float4*)s0)[lane + 64 * i]; vb[i] = ((const float4*)s1)[lane + 64 * i]; }
#pragma unroll
        for (int i = 0; i < 4; ++i) { sa += va[i].x * va[i].x + va[i].y * va[i].y + va[i].z * va[i].z + va[i].w * va[i].w; sb += vb[i].x * vb[i].x + vb[i].y * vb[i].y + vb[i].z * vb[i].z + vb[i].w * vb[i].w; }
        sa = wave_sum(sa); sb = wave_sum(sb);
        const float ra = rsqrtf(sa * (1.0f / 1024.0f) + EPSN), rb = rsqrtf(sb * (1.0f / 1024.0f) + EPSN);
#pragma unroll
        for (int i = 0; i < 4; ++i) { const float4 ga = ((const float4*)g0)[lane + 64 * i], gb = ((const float4*)g1)[lane + 64 * i];
            u32x2 wa = {pk2(va[i].x * ra * ga.x, va[i].y * ra * ga.y), pk2(va[i].z * ra * ga.z, va[i].w * ra * ga.w)};
            u32x2 wb = {pk2(vb[i].x * rb * gb.x, vb[i].y * rb * gb.y), pk2(vb[i].z * rb * gb.z, vb[i].w * rb * gb.w)};
            *(u32x2*)(d0 + (size_t)(lane + 64 * i) * 4) = wa; if (two) *(u32x2*)(d1 + (size_t)(lane + 64 * i) * 4) = wb; }
      } }
    { const size_t g = (size_t)blockIdx.x * 512 + tid, gs = (size_t)gridDim.x * 512;
      float* rs = (float*)(p.ws + W_ROWSS); for (size_t i = g; i < (size_t)MPAD; i += gs) rs[i] = 0.f; }
}

struct GDesc { const u16* A; const u16* Bt; int K; int mode; };
struct MUnit { int pm, pn, gi; };
struct MSched {
    pg8::StaticOrder so; int nsub, nreg, ex_pm, ex_pn, ex_gi, has_extra;
    DI bool next(int i, MUnit& u) const {
        const int ti = nsub == 4 ? (i >> 2) : i, gi = nsub == 4 ? (i & 3) : 0;
        pg8::Unit t;
        if (so.next(ti, t)) { u.pm = t.pm; u.pn = t.pn; u.gi = gi; return true; }
        if (has_extra && ti == nreg) { u.pm = ex_pm; u.pn = ex_pn; u.gi = ex_gi; return true; }
        return false;
    }
};
DI void epi_all(const Params& p, int mode, const f32x4 (&acc)[2][2][4][2], const MUnit& u, size_t rsoff) {
    const int tq_ = otid(), wq_ = tq_ >> 6, wr = wq_ >> 2, wc = wq_ & 3, fr = tq_ & 15, fq = (tq_ >> 4) & 3;
    const int row0 = u.pm * 256 + wr * 64 + fr, col0 = u.pn * 256 + wc * 32 + 8 * fq;
    if (mode == 0) { u16* O = (u16*)(p.ws + W_Z);
#pragma unroll
        for (int ai = 0; ai < 2; ++ai)
#pragma unroll
            for (int m = 0; m < 4; ++m) { u16* rowp = O + (size_t)(row0 + ai * 128 + m * 16) * DIN + col0;
#pragma unroll
                for (int bj = 0; bj < 2; ++bj) *(bf16x8*)(rowp + bj * 128) = pack8(acc[ai][bj][m][0], acc[ai][bj][m][1]);
                asm volatile("" ::: "memory"); }
    } else if (mode == 1) { u16* O = (u16*)(p.ws + W_MEMKV); float* F = p.out + O_MKV;
#pragma unroll
        for (int ai = 0; ai < 2; ++ai)
#pragma unroll
            for (int m = 0; m < 4; ++m) { const size_t ro = (size_t)(row0 + ai * 128 + m * 16) * 512 + col0;
#pragma unroll
                for (int bj = 0; bj < 2; ++bj) { *(bf16x8*)(O + ro + bj * 128) = pack8(acc[ai][bj][m][0], acc[ai][bj][m][1]);
                    *(f32x4*)(F + ro + bj * 128) = acc[ai][bj][m][0]; *(f32x4*)(F + ro + bj * 128 + 4) = acc[ai][bj][m][1]; }
                asm volatile("" ::: "memory"); }
    } else if (mode == 7) {
        u16* G = (u16*)(p.ws + W_GSC) + ((size_t)blockIdx.x * 3 + u.gi) * 65536 + (size_t)(wr * 64 + fr) * 256 + wc * 32 + 8 * fq;
#pragma unroll
        for (int ai = 0; ai < 2; ++ai)
#pragma unroll
            for (int m = 0; m < 4; ++m) {
#pragma unroll
                for (int bj = 0; bj < 2; ++bj) { f32x4 t0, t1;
#pragma unroll
                    for (int j = 0; j < 4; ++j) { t0[j] = 1.0f + __expf(-acc[ai][bj][m][0][j]); t1[j] = 1.0f + __expf(-acc[ai][bj][m][1][j]); }
                    *(bf16x8*)(G + (ai * 128 + m * 16) * 256 + bj * 128) = pack8(t0, t1); }
                asm volatile("" ::: "memory"); }
    } else if (mode == 6) {
        const u16* GS = (const u16*)(p.ws + W_GSC) + ((size_t)blockIdx.x * 3 + 2) * 65536 + (size_t)(wr * 64 + fr) * 256 + wc * 32 + 8 * fq; u16* merged = (u16*)(p.ws + W_MERGED);
#pragma unroll
        for (int ai = 0; ai < 2; ++ai) { u32x4 ga[4][2];
#pragma unroll
            for (int m = 0; m < 4; ++m)
#pragma unroll
                for (int bj = 0; bj < 2; ++bj) ga[m][bj] = *(const u32x4*)(GS + (ai * 128 + m * 16) * 256 + bj * 128);
#pragma unroll
            for (int m = 0; m < 4; ++m)
#pragma unroll
                for (int bj = 0; bj < 2; ++bj) { float f[8];
#pragma unroll
                    for (int j = 0; j < 4; ++j) { f[2 * j] = __builtin_amdgcn_rcpf(bflo(ga[m][bj][j])); f[2 * j + 1] = __builtin_amdgcn_rcpf(bfhi(ga[m][bj][j])); }
                    const f32x4 r0 = acc[ai][bj][m][0] * (f32x4){f[0], f[1], f[2], f[3]}, r1 = acc[ai][bj][m][1] * (f32x4){f[4], f[5], f[6], f[7]};
                    *(bf16x8*)(merged + (size_t)(row0 + ai * 128 + m * 16) * 1024 + col0 + bj * 128) = pack8(r0, r1); }
            asm volatile("" ::: "memory"); }
    } else { float* rowss = (float*)(p.ws + W_ROWSS + rsoff);
#pragma unroll
        for (int pr = 0; pr < 4; ++pr) { f32x4 xv[2][2][2];
#pragma unroll
            for (int q = 0; q < 2; ++q) { const int am = pr * 2 + q, ai = am >> 2, m = am & 3; const int row = row0 + ai * 128 + m * 16;
                const float* xr = row < NTOK_P ? p.x_prompt + (size_t)row * 1024 : p.x_sample + (size_t)(row - NTOK_P) * 1024;
#pragma unroll
                for (int bj = 0; bj < 2; ++bj)
#pragma unroll
                    for (int n = 0; n < 2; ++n) xv[q][bj][n] = *(const f32x4*)(xr + col0 + bj * 128 + n * 4); }
#pragma unroll
            for (int q = 0; q < 2; ++q) { const int am = pr * 2 + q, ai = am >> 2, m = am & 3; const int row = row0 + ai * 128 + m * 16; u16* orow = (u16*)(p.ws + W_MACC) + (size_t)row * 1024; float ss = 0.f;
#pragma unroll
                for (int bj = 0; bj < 2; ++bj)
#pragma unroll
                    for (int n = 0; n < 2; ++n) { const f32x4 r = xv[q][bj][n] + acc[ai][bj][m][n]; u32x2 wv = {pk2(r[0], r[1]), pk2(r[2], r[3])}; *(u32x2*)(orow + col0 + bj * 128 + n * 4) = wv; ss += r[0] * r[0] + r[1] * r[1] + r[2] * r[2] + r[3] * r[3]; }
                ss += __shfl_xor(ss, 16); ss += __shfl_xor(ss, 32);
                if (fq == 0) atomicAdd(rowss + row, ss); }
            asm volatile("" ::: "memory"); }
    }
}
DI void epi_fused(const Params& p, PG8_LAS unsigned char* lds, f32x4 (&acc)[2][2][4][2], const MUnit& u, size_t rsoff) {
    const int tq_ = otid(), wq_ = tq_ >> 6, wr = wq_ >> 2, wc = wq_ & 3, fr = tq_ & 15, fq = (tq_ >> 4) & 3;
    const int row0 = u.pm * 256 + wr * 64 + fr, col0 = u.pn * 256 + wc * 32 + 8 * fq;
    float* rowss = (float*)(p.ws + W_ROWSS + rsoff);
    unsigned* cnt = (unsigned*)(p.ws + W_CNT) + 64 * u.pm;
#pragma unroll
    for (int pr = 0; pr < 4; ++pr) { f32x4 xv[2][2][2];
#pragma unroll
        for (int q = 0; q < 2; ++q) { const int am = pr * 2 + q, ai = am >> 2, m = am & 3; const float* xr = p.x_prompt + (size_t)(row0 + ai * 128 + m * 16) * 1024;
#pragma unroll
            for (int bj = 0; bj < 2; ++bj)
#pragma unroll
                for (int n = 0; n < 2; ++n) xv[q][bj][n] = *(const f32x4*)(xr + col0 + bj * 128 + n * 4); }
#pragma unroll
        for (int q = 0; q < 2; ++q) { const int am = pr * 2 + q, ai = am >> 2, m = am & 3; float ss = 0.f;
#pragma unroll
            for (int bj = 0; bj < 2; ++bj)
#pragma unroll
                for (int n = 0; n < 2; ++n) { const f32x4 r = xv[q][bj][n] + acc[ai][bj][m][n]; acc[ai][bj][m][n] = r; ss += r[0] * r[0] + r[1] * r[1] + r[2] * r[2] + r[3] * r[3]; }
            ss += __shfl_xor(ss, 16); ss += __shfl_xor(ss, 32);
            if (fq == 0) atomicAdd(rowss + row0 + ai * 128 + m * 16, ss); }
        asm volatile("" ::: "memory"); }
    asm volatile("s_waitcnt vmcnt(0)" ::: "memory");
    __syncthreads();
    if (tq_ == 0) { __hip_atomic_fetch_add(cnt, 1u, __ATOMIC_RELAXED, __HIP_MEMORY_SCOPE_AGENT); unsigned sp = 0;
        while (__hip_atomic_load(cnt, __ATOMIC_RELAXED, __HIP_MEMORY_SCOPE_AGENT) < 4u) { __builtin_amdgcn_s_sleep(1); if (++sp > (1u << 20)) break; } }
    __syncthreads();
    PG8_LAS float* S = (PG8_LAS float*)lds;
    if (tq_ < 256) { const unsigned tb = __hip_atomic_load((unsigned*)(rowss + u.pm * 256 + tq_), __ATOMIC_RELAXED, __HIP_MEMORY_SCOPE_AGENT); S[tq_] = rsqrtf(__uint_as_float(tb) * (1.0f / 1024.0f) + EPSN); }
    __syncthreads();
    f32x4 gn[2][2];
#pragma unroll
    for (int bj = 0; bj < 2; ++bj)
#pragma unroll
        for (int n = 0; n < 2; ++n) gn[bj][n] = *(const f32x4*)(p.norm_final + col0 + bj * 128 + n * 4);
#pragma unroll
    for (int ai = 0; ai < 2; ++ai)
#pragma unroll
        for (int m = 0; m < 4; ++m) { const float rs = S[wr * 64 + fr + ai * 128 + m * 16]; float* orow = p.out + (size_t)(row0 + ai * 128 + m * 16) * 1024 + col0;
#pragma unroll
            for (int bj = 0; bj < 2; ++bj)
#pragma unroll
                for (int n = 0; n < 2; ++n) *(f32x4*)(orow + bj * 128 + n * 4) = acc[ai][bj][m][n] * rs * gn[bj][n]; }
}
DI void gate_scale(const Params& p, f32x4 (&acc)[2][2][4][2], const MUnit& u, int which) {
    const int tq_ = otid(), wq_ = tq_ >> 6, wr = wq_ >> 2, wc = wq_ & 3, fr = tq_ & 15, fq = (tq_ >> 4) & 3;
    const int row0 = u.pm * 256 + wr * 64 + fr, col0 = u.pn * 256 + wc * 32 + 8 * fq;
    const u16* GS = (const u16*)(p.ws + W_GSC) + ((size_t)blockIdx.x * 3 + which) * 65536 + (size_t)(wr * 64 + fr) * 256 + wc * 32 + 8 * fq;
#pragma unroll
    for (int pr = 0; pr < 4; ++pr) { u32x4 ga[2][2], gb[2][2];
#pragma unroll
        for (int q = 0; q < 2; ++q) { const int am = pr * 2 + q, ai = am >> 2, m = am & 3;
#pragma unroll
            for (int bj = 0; bj < 2; ++bj) { const u16* zp = GS + (ai * 128 + m * 16) * 256 + bj * 128; ga[q][bj] = *(const u32x4*)zp; gb[q][bj] = *(const u32x4*)(zp + 65536); } }
#pragma unroll
        for (int q = 0; q < 2; ++q) { const int am = pr * 2 + q, ai = am >> 2, m = am & 3;
#pragma unroll
            for (int bj = 0; bj < 2; ++bj) { float f[8];
#pragma unroll
                for (int j = 0; j < 4; ++j) { f[2 * j] = bflo(gb[q][bj][j]) * __builtin_amdgcn_rcpf(bflo(ga[q][bj][j]));
                    f[2 * j + 1] = bfhi(gb[q][bj][j]) * __builtin_amdgcn_rcpf(bfhi(ga[q][bj][j])); }
                acc[ai][bj][m][0] *= (f32x4){f[0], f[1], f[2], f[3]}; acc[ai][bj][m][1] *= (f32x4){f[4], f[5], f[6], f[7]}; } }
        asm volatile("" ::: "memory"); }
}
DI void gemm_multi(PG8_LAS unsigned char* lds, const Params& p, const GDesc d0, const GDesc d1, const GDesc d2, const GDesc d3, const MSched& S, size_t rsoff) {
    using namespace pg8;
    const int tid = otid(), wid = __builtin_amdgcn_readfirstlane(tid >> 6), lane = tid & 63, wr = wid >> 2, wc = wid & 3, fr = lane & 15, fq = lane >> 4;
    unsigned ra2[2], rb2[2], c2[2];
#pragma unroll
    for (int i = 0; i < 2; ++i) { int R, C; stage_rc(tid * 16 + i * 8192, R, C); ra2[i] = (unsigned)R * 2u; rb2[i] = (unsigned)((R & ~31) + perm32(R & 31)) * 2u; c2[i] = (unsigned)C * 2u; }
    const size_t kstep = (size_t)(BK * 2);
    const unsigned ldsw = (unsigned)wid * 1024u;
    const int aoff = lds_byte(wr * 64 + fr, fq * 8), boff = lds_byte(wc * 32 + fr, fq * 8);
#define PG8_SA(b, h) (((b) * 2 + (h)) * HTB)
#define PG8_SB(b, h) ((4 + (b) * 2 + (h)) * HTB)
#define PG8_STAGE(bufoff, gbase, voff) do { _Pragma("unroll") for (int _i = 0; _i < 2; ++_i) \
        __builtin_amdgcn_global_load_lds((const unsigned*)((const char*)(gbase) + (voff)[_i]), (PG8_LAS unsigned*)(lds + (bufoff) + ldsw + _i * 8192), 16, 0, 0); } while (0)
#define PG8_LDA(dst, b, h) do { _Pragma("unroll") for (int m = 0; m < 4; ++m) _Pragma("unroll") for (int k = 0; k < 2; ++k) dst[m][k] = *(const PG8_LAS bf16x8*)(lds + PG8_SA(b, h) + aoff + m * 2048 + k * 1024); } while (0)
#define PG8_LDB(dst, b, h) do { _Pragma("unroll") for (int n = 0; n < 2; ++n) _Pragma("unroll") for (int k = 0; k < 2; ++k) dst[n][k] = *(const PG8_LAS bf16x8*)(lds + PG8_SB(b, h) + boff + n * 2048 + k * 1024); } while (0)
#define PG8_MMA(ai, bj, At, Bt) do { __builtin_amdgcn_s_setprio(1); _Pragma("unroll") for (int m = 0; m < 4; ++m) _Pragma("unroll") for (int n = 0; n < 2; ++n) _Pragma("unroll") for (int k = 0; k < 2; ++k) \
        acc[ai][bj][m][n] = __builtin_amdgcn_mfma_f32_16x16x32_bf16(Bt[n][k], At[m][k], acc[ai][bj][m][n], 0, 0, 0); __builtin_amdgcn_s_setprio(0); } while (0)
#define PG8_WAIT_V(n) asm volatile("s_waitcnt vmcnt(" #n ")" ::: "memory")
#define PG8_WAIT_L(n) asm volatile("s_waitcnt lgkmcnt(" #n ")" ::: "memory")
#define PG8_BAR __builtin_amdgcn_s_barrier()
#define PG8_SCHED __builtin_amdgcn_sched_barrier(0)
#define GSEL(gi, f) ((gi) == 0 ? d0.f + 0 : ((gi) == 1 ? d1.f + 0 : ((gi) == 2 ? d2.f + 0 : d3.f + 0)))
    MUnit cur, nxt; int ui = 0;
    if (!S.next(0, cur)) return;
    f32x4 acc[2][2][4][2];
#pragma unroll
    for (int a = 0; a < 2; ++a)
#pragma unroll
        for (int b = 0; b < 2; ++b)
#pragma unroll
            for (int m = 0; m < 4; ++m)
#pragma unroll
                for (int n = 0; n < 2; ++n) acc[a][b][m][n] = (f32x4){0.f, 0.f, 0.f, 0.f};
    bf16x8 At[4][2], B0[2][2], B1[2][2];
    int Kc = GSEL(cur.gi, K); int modec = GSEL(cur.gi, mode);
    const char* cA = (const char*)GSEL(cur.gi, A) + (size_t)cur.pm * ((size_t)512 * Kc); const char* cB = (const char*)GSEL(cur.gi, Bt) + (size_t)cur.pn * ((size_t)512 * Kc);
    {
        const size_t hstep = (size_t)HALF * Kc * 2; unsigned vA[2], vB[2];
#pragma unroll
        for (int i = 0; i < 2; ++i) { vA[i] = ra2[i] * (unsigned)Kc + c2[i]; vB[i] = rb2[i] * (unsigned)Kc + c2[i]; }
        PG8_STAGE(PG8_SB(0, 0), cB, vB); PG8_STAGE(PG8_SA(0, 0), cA, vA); PG8_STAGE(PG8_SB(0, 1), cB + hstep, vB); PG8_STAGE(PG8_SA(0, 1), cA + hstep, vA);
        if (wr == 1) PG8_BAR;
        PG8_WAIT_V(4); PG8_BAR;
        PG8_STAGE(PG8_SB(1, 0), cB + kstep, vB); PG8_STAGE(PG8_SA(1, 0), cA + kstep, vA); PG8_STAGE(PG8_SB(1, 1), cB + hstep + kstep, vB);
        PG8_WAIT_V(6); PG8_BAR;
    }
    for (;;) {
        const bool has_next = S.next(ui + 1, nxt);
        const int Kn = has_next ? GSEL(nxt.gi, K) : Kc; const int moden = has_next ? GSEL(nxt.gi, mode) : modec;
        const char* nA = has_next ? (const char*)GSEL(nxt.gi, A) + (size_t)nxt.pm * ((size_t)512 * Kn) : cA; const char* nB = has_next ? (const char*)GSEL(nxt.gi, Bt) + (size_t)nxt.pn * ((size_t)512 * Kn) : cB;
        const int nt = Kc / BK; const size_t hstepc = (size_t)HALF * Kc * 2;
        unsigned vAc[2];
#pragma unroll
        for (int i = 0; i < 2; ++i) vAc[i] = ra2[i] * (unsigned)Kc + c2[i];
        for (int t = 0; t < nt; t += 2) {
            const bool last = (t == nt - 2);
            const int K2 = last ? Kn : Kc; const size_t hstep2 = (size_t)HALF * K2 * 2;
            unsigned vA2[2], vB2[2];
#pragma unroll
            for (int i = 0; i < 2; ++i) { vA2[i] = ra2[i] * (unsigned)K2 + c2[i]; vB2[i] = rb2[i] * (unsigned)K2 + c2[i]; }
            const char* a1 = cA + (size_t)(t + 1) * kstep;
            const char* a2 = last ? nA : cA + (size_t)(t + 2) * kstep; const char* b2 = last ? nB : cB + (size_t)(t + 2) * kstep;
            const char* a3 = a2 + kstep; const char* b3 = b2 + kstep;
            PG8_LDB(B0, 0, 0); PG8_SCHED; PG8_LDA(At, 0, 0); PG8_STAGE(PG8_SA(1, 1), a1 + hstepc, vAc);
            PG8_WAIT_L(8); PG8_BAR; PG8_WAIT_L(0); PG8_MMA(0, 0, At, B0); PG8_BAR; PG8_SCHED;
            PG8_LDB(B1, 0, 1); PG8_STAGE(PG8_SB(0, 0), b2, vB2);
            PG8_BAR; PG8_WAIT_L(0); PG8_MMA(0, 1, At, B1); PG8_BAR;
            PG8_LDA(At, 0, 1); PG8_STAGE(PG8_SA(0, 0), a2, vA2);
            PG8_BAR; PG8_WAIT_L(0); PG8_MMA(1, 0, At, B0); PG8_BAR; PG8_SCHED;
            PG8_STAGE(PG8_SB(0, 1), b2 + hstep2, vB2);
            PG8_WAIT_V(6); PG8_BAR; PG8_MMA(1, 1, At, B1); PG8_BAR;
            PG8_LDB(B0, 1, 0); PG8_SCHED; PG8_LDA(At, 1, 0); PG8_STAGE(PG8_SA(0, 1), a2 + hstep2, vA2);
            PG8_WAIT_L(8); PG8_BAR; PG8_WAIT_L(0); PG8_MMA(0, 0, At, B0); PG8_BAR; PG8_SCHED;
            PG8_LDB(B1, 1, 1); PG8_STAGE(PG8_SB(1, 0), b3, vB2);
            PG8_BAR; PG8_WAIT_L(0); PG8_MMA(0, 1, At, B1); PG8_BAR;
            PG8_LDA(At, 1, 1); PG8_STAGE(PG8_SA(1, 0), a3, vA2);
            PG8_BAR; PG8_WAIT_L(0); PG8_MMA(1, 0, At, B0); PG8_BAR; PG8_SCHED;
            PG8_STAGE(PG8_SB(1, 1), b3 + hstep2, vB2);
            PG8_WAIT_V(6); PG8_BAR; PG8_MMA(1, 1, At, B1); PG8_BAR;
            if (modec == 6 && (t == 2 || t == 10)) gate_scale(p, acc, cur, t == 2 ? 0 : 1);
        }
        if (modec != 5) epi_all(p, modec, acc, cur, rsoff);
        if (!has_next) break;
#pragma unroll
        for (int a = 0; a < 2; ++a)
#pragma unroll
            for (int b = 0; b < 2; ++b)
#pragma unroll
                for (int m = 0; m < 4; ++m)
#pragma unroll
                    for (int n = 0; n < 2; ++n) acc[a][b][m][n] = (f32x4){0.f, 0.f, 0.f, 0.f};
        cur = nxt; cA = nA; cB = nB; Kc = Kn; modec = moden; ++ui;
    }
    PG8_WAIT_V(0);
    if (wr == 0) PG8_BAR;
    PG8_BAR;
    if (modec == 5) epi_fused(p, lds, acc, cur, rsoff);
#undef GSEL
#undef PG8_SA
#undef PG8_SB
#undef PG8_STAGE
#undef PG8_LDA
#undef PG8_LDB
#undef PG8_MMA
#undef PG8_WAIT_V
#undef PG8_WAIT_L
#undef PG8_BAR
#undef PG8_SCHED
}

DI void wg_publish(unsigned* cnt) {
    asm volatile("s_waitcnt vmcnt(0)" ::: "memory");
    __syncthreads();
    if (threadIdx.x == 0) { __builtin_amdgcn_fence(__ATOMIC_RELEASE, "agent"); asm volatile("s_waitcnt vmcnt(0)" ::: "memory"); __hip_atomic_fetch_add(cnt, 1u, __ATOMIC_RELAXED, __HIP_MEMORY_SCOPE_AGENT); }
}
DI void wg_consume(unsigned* cnt, unsigned need) {
    if (threadIdx.x == 0) { unsigned sp = 0;
        while (__hip_atomic_load(cnt, __ATOMIC_RELAXED, __HIP_MEMORY_SCOPE_AGENT) < need) { __builtin_amdgcn_s_sleep(1); if (++sp > (1u << 20)) break; }
        __builtin_amdgcn_fence(__ATOMIC_ACQUIRE, "agent"); asm volatile("s_waitcnt vmcnt(0)" ::: "memory"); }
    __syncthreads();
}
DI void sk_range(f32x4 (&acc)[2], const u16* ap, const u16* bp0, const u16* bp1, int k0, int k1) {
#pragma unroll 8
    for (int k = k0; k < k1; k += 32) { const bf16x8 a = *(const bf16x8*)(ap + k), b0 = *(const bf16x8*)(bp0 + k), b1 = *(const bf16x8*)(bp1 + k);
        acc[0] = MFMA16(b0, a, acc[0]); acc[1] = MFMA16(b1, a, acc[1]); }
}
DI void skinny_tile(const Params& p, int mode, const u16* A, const u16* Bt, int grow0, int n0, size_t rsoff = 0) {
    const int tid = otid(), w = tid >> 6, lane = tid & 63, l15 = lane & 15, g4 = lane >> 4;
    f32x4 acc[2]; acc[0] = (f32x4){0.f, 0.f, 0.f, 0.f}; acc[1] = acc[0];
    const u16* ap = A + (size_t)(16 * w + l15) * 1024 + 8 * g4;
    const u16* bp0 = Bt + (size_t)(n0 + l15) * 1024 + 8 * g4; const u16* bp1 = bp0 + 16 * 1024;
    const size_t grow = (size_t)grow0 + 16 * w + l15;
    const u16* Z = (const u16*)(p.ws + W_Z);
    if (mode == 2) {
        sk_range(acc, ap, bp0, bp1, 0, 256);
#pragma unroll
        for (int which = 0; which < 2; ++which) {
#pragma unroll
            for (int jb = 0; jb < 2; ++jb) { const u16* zp = Z + grow * 8192 + C_ZG + which * 1024 + n0 + 16 * jb + 4 * g4; const u32x2 ga = *(const u32x2*)zp, gb = *(const u32x2*)(zp + 1024);
                acc[jb][0] *= (1.0f + __expf(-bflo(gb[0]))) * __builtin_amdgcn_rcpf(1.0f + __expf(-bflo(ga[0]))); acc[jb][1] *= (1.0f + __expf(-bfhi(gb[0]))) * __builtin_amdgcn_rcpf(1.0f + __expf(-bfhi(ga[0])));
                acc[jb][2] *= (1.0f + __expf(-bflo(gb[1]))) * __builtin_amdgcn_rcpf(1.0f + __expf(-bflo(ga[1]))); acc[jb][3] *= (1.0f + __expf(-bfhi(gb[1]))) * __builtin_amdgcn_rcpf(1.0f + __expf(-bfhi(ga[1]))); }
            if (which == 0) sk_range(acc, ap, bp0, bp1, 256, 768); else sk_range(acc, ap, bp0, bp1, 768, 1024); }
    } else sk_range(acc, ap, bp0, bp1, 0, 1024);
    float ss = 0.f;
#pragma unroll
    for (int jb = 0; jb < 2; ++jb) { const int n = n0 + 16 * jb + 4 * g4; const f32x4 v = acc[jb];
        if (mode == 0) { u32x2 wv = {pk2(v[0], v[1]), pk2(v[2], v[3])}; *(u32x2*)((u16*)(p.ws + W_Z) + grow * 8192 + n) = wv; }
        else if (mode == 1) { u32x2 wv = {pk2(v[0], v[1]), pk2(v[2], v[3])}; *(u32x2*)((u16*)(p.ws + W_MEMKV) + grow * 512 + n) = wv; *(f32x4*)(p.out + O_MKV + grow * 512 + n) = v; }
        else if (mode == 2) { const u32x2 gz = *(const u32x2*)(Z + grow * 8192 + C_ZG + 2048 + n);
            u32x2 wv = {pk2(v[0] * sigmoidf_(bflo(gz[0])), v[1] * sigmoidf_(bfhi(gz[0]))), pk2(v[2] * sigmoidf_(bflo(gz[1])), v[3] * sigmoidf_(bfhi(gz[1])))};
            *(u32x2*)((u16*)(p.ws + W_MERGED) + grow * 1024 + n) = wv; }
        else { const f32x4 r = *(const f32x4*)(p.x_sample + (grow - NTOK_P) * 1024 + n) + v; acc[jb] = r; ss += r[0] * r[0] + r[1] * r[1] + r[2] * r[2] + r[3] * r[3]; } }
    if (mode == 3) {
        float* rowss = (float*)(p.ws + W_ROWSS + rsoff); unsigned* cnt = (unsigned*)(p.ws + W_CNT) + 64 * 64;
        ss += __shfl_xor(ss, 16); ss += __shfl_xor(ss, 32); if (g4 == 0) atomicAdd(rowss + grow, ss);
        asm volatile("s_waitcnt vmcnt(0)" ::: "memory");
        __syncthreads();
        if (tid == 0) { __hip_atomic_fetch_add(cnt, 1u, __ATOMIC_RELAXED, __HIP_MEMORY_SCOPE_AGENT); unsigned sp = 0;
            while (__hip_atomic_load(cnt, __ATOMIC_RELAXED, __HIP_MEMORY_SCOPE_AGENT) < 32u) { __builtin_amdgcn_s_sleep(1); if (++sp > (1u << 20)) break; } }
        __syncthreads();
        const unsigned tb = __hip_atomic_load((unsigned*)(rowss + grow), __ATOMIC_RELAXED, __HIP_MEMORY_SCOPE_AGENT); const float rs = rsqrtf(__uint_as_float(tb) * (1.0f / 1024.0f) + EPSN);
#pragma unroll
        for (int jb = 0; jb < 2; ++jb) { const int n = n0 + 16 * jb + 4 * g4; *(f32x4*)(p.out + grow * 1024 + n) = acc[jb] * rs * *(const f32x4*)(p.norm_final + n); } }
}
DI void phase_skinny(const Params& p, int ph, size_t rsoff) {
    if (ph == 1) { for (int it = blockIdx.x; it < 256; it += gridDim.x) {
            if (it < 256) skinny_tile(p, 0, (const u16*)(p.ws + W_H) + (size_t)NTOK_P * 1024, (const u16*)(p.ws + W_WINT), NTOK_P, it * 32);
            else { const int q = it - 256, rg = q >> 4, cb = q & 15; skinny_tile(p, 1, (const u16*)(p.ws + W_HM) + (size_t)rg * 128 * 1024, (const u16*)(p.ws + W_WMEMT), rg * 128, cb * 32); } } }
    else if (ph == 5) { for (int it = blockIdx.x; it < 32; it += gridDim.x) skinny_tile(p, 2, (const u16*)(p.ws + W_UA) + (size_t)NTOK_P * 1024, (const u16*)(p.ws + W_WAT), NTOK_P, it * 32); }
    else { for (int it = blockIdx.x; it < 32; it += gridDim.x) skinny_tile(p, 3, (const u16*)(p.ws + W_MERGED) + (size_t)NTOK_P * 1024, (const u16*)(p.ws + W_WOUTT), NTOK_P, it * 32, rsoff); }
}

struct AttnItem { int is_mem, b, h, grp, dil, r, nb; };
struct AttnRegs { uint4 k[4], va[2], vb[2]; bf16x8 q0, q1; };
DI AttnItem attn_decode(int idx  ) {
    AttnItem a; a.grp = 0; a.dil = 1; a.r = 0;
    if (idx >= 1536) { idx -= 1536; a.is_mem = 1; a.b = idx >> 8; a.h = (idx >> 6) & 3; a.nb = idx & 63; }
    else { a.is_mem = 0; a.grp = idx >> 9; const int rem = idx & 511; a.b = rem >> 8; a.h = (rem >> 6) & 3; const int c = rem & 63; a.dil = a.grp == 0 ? 1 : (a.grp == 1 ? 4 : 16);
           const int nbc = 64 / a.dil; a.r = c / nbc; a.nb = c % nbc; }
    return a;
}
DI size_t attn_qrow(const AttnItem& a, int qi) { return a.is_mem ? ((size_t)a.b * 8192 + a.nb * 128 + qi) : ((size_t)a.b * 8192 + (size_t)(a.nb * 128 + qi) * a.dil + a.r); }
DI void attn_load(const Params& p, const AttnItem& a, AttnRegs& R) {
    const u16* Z = (const u16*)(p.ws + W_Z); const u16* MK = (const u16*)(p.ws + W_MEMKV);
    const int tid = otid(), w = tid >> 6, lane = tid & 63, l15 = lane & 15, g4 = lane >> 4;
    const uint4 z4 = {0u, 0u, 0u, 0u};
#pragma unroll
    for (int it = 0; it < 4; ++it) { const int c = tid + 512 * it, kr = c >> 3, seg = c & 7; uint4 v = z4;
        if (a.is_mem) v = *(const uint4*)(MK + (size_t)(a.b * 256 + kr) * 512 + a.h * 64 + seg * 8);
        else { const int uu = (a.nb - 1) * 128 + kr; if (uu >= 0) v = *(const uint4*)(Z + ((size_t)a.b * 8192 + (size_t)uu * a.dil + a.r) * 8192 + C_KA + a.grp * 256 + a.h * 64 + seg * 8); }
        R.k[it] = v; }
#pragma unroll
    for (int it = 0; it < 2; ++it) { const int un = tid + 512 * it, seg = un & 7, kp = un >> 3; uint4 va = z4, vb = z4;
        if (a.is_mem) { const u16* s = MK + (size_t)(a.b * 256 + 2 * kp) * 512 + 256 + a.h * 64 + seg * 8; va = *(const uint4*)s; vb = *(const uint4*)(s + 512); }
        else { const int uu = (a.nb - 1) * 128 + 2 * kp; if (uu >= 0) { const u16* s = Z + ((size_t)a.b * 8192 + (size_t)uu * a.dil + a.r) * 8192 + C_VA + a.grp * 256 + a.h * 64 + seg * 8;
                   va = *(const uint4*)s; vb = *(const uint4*)(s + (size_t)a.dil * 8192); } }
        R.va[it] = va; R.vb[it] = vb; }
    const u16* qp = Z + attn_qrow(a, 16 * w + l15) * 8192 + (a.is_mem ? C_QM : C_QA + a.grp * 256) + a.h * 64 + g4 * 8;
    R.q0 = *(const bf16x8*)qp; R.q1 = *(const bf16x8*)(qp + 32);
}
DI void attn_stage(char* smem, const AttnRegs& R) {
    const int tid = otid();
    u16* Ks = (u16*)smem;
    unsigned* VT = (unsigned*)(smem + 36864);
#pragma unroll
    for (int it = 0; it < 4; ++it) { const int c = tid + 512 * it, kr = c >> 3, seg = c & 7; *(uint4*)(Ks + kr * 72 + seg * 8) = R.k[it]; }
#pragma unroll
    for (int it = 0; it < 2; ++it) { const int un = tid + 512 * it, seg = un & 7, kp = un >> 3; const uint4 va = R.va[it], vb = R.vb[it];
        unsigned* d = VT + (seg * 8) * 129 + kp;
        d[0 * 129] = (va.x & 0xffffu) | (vb.x << 16); d[1 * 129] = (va.x >> 16) | (vb.x & 0xffff0000u);
        d[2 * 129] = (va.y & 0xffffu) | (vb.y << 16); d[3 * 129] = (va.y >> 16) | (vb.y & 0xffff0000u);
        d[4 * 129] = (va.z & 0xffffu) | (vb.z << 16); d[5 * 129] = (va.z >> 16) | (vb.z & 0xffff0000u);
        d[6 * 129] = (va.w & 0xffffu) | (vb.w << 16); d[7 * 129] = (va.w >> 16) | (vb.w & 0xffff0000u); }
}
DI void attn_compute(const Params& p, char* smem, const AttnItem& a, const bf16x8 qf0, const bf16x8 qf1) {
    const u16* Z = (const u16*)(p.ws + W_Z);
    const int tid = otid(), w = tid >> 6, lane = tid & 63, l15 = lane & 15, g4 = lane >> 4;
    const u16* Ks = (const u16*)smem; const unsigned* VT = (const unsigned*)(smem + 36864);
    const bool is_mem = a.is_mem != 0; const int nb = a.nb, h = a.h, grp = a.grp;
    const int qi = 16 * w + l15; const size_t qrow = attn_qrow(a, qi);
    f32x4 s[16];
#pragma unroll
    for (int kg = 0; kg < 4; ++kg) { bf16x8 ka[4][2];
#pragma unroll
        for (int i = 0; i < 4; ++i) { const u16* kp_ = Ks + ((kg * 4 + i) * 16 + l15) * 72 + g4 * 8; ka[i][0] = *(const bf16x8*)kp_; ka[i][1] = *(const bf16x8*)(kp_ + 32); }
        __builtin_amdgcn_sched_barrier(0);
#pragma unroll
        for (int i = 0; i < 4; ++i) { f32x4 acc = {0.f, 0.f, 0.f, 0.f}; acc = MFMA16(ka[i][0], qf0, acc); acc = MFMA16(ka[i][1], qf1, acc); s[kg * 4 + i] = acc; }
        __builtin_amdgcn_sched_barrier(0); }
    float mx = -1e30f;
#pragma unroll
    for (int kb = 0; kb < 16; ++kb)
#pragma unroll
        for (int j = 0; j < 4; ++j) { const int kj = kb * 16 + g4 * 4 + j; float v = s[kb][j] * 0.125f;
            const bool ok = is_mem || (kb < 8 ? (kj >= qi && nb > 0) : (kj - 128 <= qi));
            v = ok ? v : -1e30f; s[kb][j] = v; mx = fmaxf(mx, v); }
    mx = fmaxf(mx, __shfl_xor(mx, 16)); mx = fmaxf(mx, __shfl_xor(mx, 32));
    float l = 0.f;
#pragma unroll
    for (int kb = 0; kb < 16; ++kb)
#pragma unroll
        for (int j = 0; j < 4; ++j) { const float e = __expf(s[kb][j] - mx); s[kb][j] = e; l += e; }
    l += __shfl_xor(l, 16); l += __shfl_xor(l, 32);
    f32x4 o[4];
#pragma unroll
    for (int db = 0; db < 4; ++db) o[db] = (f32x4){0.f, 0.f, 0.f, 0.f};
#pragma unroll
    for (int k2 = 0; k2 < 4; ++k2) { unsigned vr[2][4][4];
#pragma unroll
        for (int q = 0; q < 2; ++q)
#pragma unroll
            for (int db = 0; db < 4; ++db) { const unsigned* vp = VT + (db * 16 + l15) * 129 + 16 * (2 * k2 + q) + 2 * g4; vr[q][db][0] = vp[0]; vr[q][db][1] = vp[1]; vr[q][db][2] = vp[8]; vr[q][db][3] = vp[9]; }
        const bf16x8 pf0 = pack8(s[4 * k2], s[4 * k2 + 1]), pf1 = pack8(s[4 * k2 + 2], s[4 * k2 + 3]);
        __builtin_amdgcn_sched_barrier(0);
#pragma unroll
        for (int db = 0; db < 4; ++db) o[db] = MFMA16(mk8(vr[0][db][0], vr[0][db][1], vr[0][db][2], vr[0][db][3]), pf0, o[db]);
#pragma unroll
        for (int db = 0; db < 4; ++db) o[db] = MFMA16(mk8(vr[1][db][0], vr[1][db][1], vr[1][db][2], vr[1][db][3]), pf1, o[db]);
        __builtin_amdgcn_sched_barrier(0); }
    const float inv = 1.0f / l;
    if (is_mem) { u16* UM = (u16*)(p.ws + W_UA) + 768;
#pragma unroll
        for (int db = 0; db < 4; ++db) { const int c = h * 64 + db * 16 + 4 * g4; const u32x2 gw = *(const u32x2*)(Z + qrow * 8192 + C_GM + c);
            u32x2 wv = {pk2(o[db][0] * inv * siluf_(bflo(gw[0])), o[db][1] * inv * siluf_(bfhi(gw[0]))), pk2(o[db][2] * inv * siluf_(bflo(gw[1])), o[db][3] * inv * siluf_(bfhi(gw[1])))};
            *(u32x2*)(UM + qrow * 1024 + c) = wv; } }
    else { u16* OA = (u16*)(p.ws + W_OA); float* LSE = (float*)(p.ws + W_LSE); const size_t ro = (size_t)grp * NTOK + qrow;
#pragma unroll
        for (int db = 0; db < 4; ++db) { u32x2 wv = {pk2(o[db][0] * inv, o[db][1] * inv), pk2(o[db][2] * inv, o[db][3] * inv)};
            *(u32x2*)(OA + ro * 256 + h * 64 + db * 16 + 4 * g4) = wv; }
        if (g4 == 0) LSE[ro * 4 + h] = mx + __logf(l); }
}

DI void hg_local(const Params& p, char* smem, int item) {
    const u16* Z = (const u16*)(p.ws + W_Z);
    const int tid = otid(), w = tid >> 6, lane = tid & 63, l15 = lane & 15, g4 = lane >> 4;
    const int bh = item >> 5, sc = item & 31, b = bh >> 2, h = bh & 3;
    const size_t row0 = (size_t)b * 8192 + sc * 256;
    u16* KT = (u16*)smem;
    u16* VT = (u16*)(smem + 34816);
    float* segprod = (float*)(smem + 69632);
    float* carry = segprod + 512;
    const int dk = tid & 127, seg = tid >> 7;
    const float lb = 1.0f / (1.0f + __expf(p.lb_logits[512 + h * 128 + dk] - p.lb_logits[h * 128 + dk]));
    if (tid < 128) carry[tid] = 1.0f;
    f32x4 S[8];
#pragma unroll
    for (int i = 0; i < 8; ++i) S[i] = (f32x4){0.f, 0.f, 0.f, 0.f};
    for (int c = 1; c >= 0; --c) {
        const size_t rbase = row0 + c * 128 + seg * 32;
        float f[32]; float prod = 1.0f;
#pragma unroll
        for (int i = 0; i < 32; ++i) { const float fb = bf2f(Z[(rbase + i) * 8192 + C_FB + h * 128 + dk]); f[i] = lb + (1.0f - lb) * sigmoidf_(fb); prod *= f[i]; }
        segprod[seg * 128 + dk] = prod;
#pragma unroll
        for (int i8 = 0; i8 < 4; ++i8) { unsigned wv[4];
#pragma unroll
            for (int j = 0; j < 4; ++j) { const unsigned lo = Z[(rbase + i8 * 8 + 2 * j) * 8192 + C_IB + h * 128 + dk], hi = Z[(rbase + i8 * 8 + 2 * j + 1) * 8192 + C_IB + h * 128 + dk]; wv[j] = lo | (hi << 16); }
            *(u32x4*)(VT + dk * 136 + seg * 32 + i8 * 8) = (u32x4){wv[0], wv[1], wv[2], wv[3]}; }
        __syncthreads();
        float run = carry[dk];
        for (int s2 = seg + 1; s2 < 4; ++s2) run *= segprod[s2 * 128 + dk];
#pragma unroll
        for (int i8 = 3; i8 >= 0; --i8) { float kt[8];
#pragma unroll
            for (int j = 7; j >= 0; --j) { const int i = i8 * 8 + j; kt[j] = (1.0f - f[i]) * run; run *= f[i]; }
            *(u32x4*)(KT + dk * 136 + seg * 32 + i8 * 8) = (u32x4){pk2(kt[0], kt[1]), pk2(kt[2], kt[3]), pk2(kt[4], kt[5]), pk2(kt[6], kt[7])}; }
        __syncthreads();
#pragma unroll
        for (int ks = 0; ks < 4; ++ks) { const bf16x8 bv = *(const bf16x8*)(VT + (16 * w + l15) * 136 + ks * 32 + g4 * 8); bf16x8 av[8];
#pragma unroll
            for (int blk = 0; blk < 8; ++blk) av[blk] = *(const bf16x8*)(KT + (16 * blk + l15) * 136 + ks * 32 + g4 * 8);
            __builtin_amdgcn_sched_barrier(0);
#pragma unroll
            for (int blk = 0; blk < 8; ++blk) S[blk] = MFMA16(av[blk], bv, S[blk]);
            __builtin_amdgcn_sched_barrier(0); }
        __syncthreads();
        if (tid < 128) carry[tid] = carry[tid] * segprod[tid] * segprod[128 + tid] * segprod[256 + tid] * segprod[384 + tid];
        __syncthreads();
    }
    float* ASC = (float*)(p.ws + W_ASC); float* SLOC = (float*)(p.ws + W_SLOC) + (size_t)item * 16384;
    if (tid < 128) ASC[item * 128 + tid] = carry[tid];
#pragma unroll
    for (int blk = 0; blk < 8; ++blk)
#pragma unroll
        for (int j = 0; j < 4; ++j) SLOC[(16 * blk + 4 * g4 + j) * 128 + 16 * w + l15] = S[blk][j];
    asm volatile("s_waitcnt vmcnt(0)" ::: "memory");
    __syncthreads();
    if (tid == 0) { __builtin_amdgcn_fence(__ATOMIC_RELEASE, "agent"); asm volatile("s_waitcnt vmcnt(0)" ::: "memory");
        __hip_atomic_fetch_add((unsigned*)(p.ws + W_BAR), 1u, __ATOMIC_RELAXED, __HIP_MEMORY_SCOPE_AGENT); }
}

DI void hg_out(const Params& p, char* smem, int item) {
    const u16* Z = (const u16*)(p.ws + W_Z);
    const int tid = otid(), w = tid >> 6, lane = tid & 63, l15 = lane & 15, g4 = lane >> 4;
    const int bh = item >> 5, sc = item & 31, b = bh >> 2, h = bh & 3;
    const size_t row0 = (size_t)b * 8192 + sc * 256;
    u16* QT = (u16*)smem;
    u16* KH = (u16*)(smem + 8704);
    u16* KT = (u16*)(smem + 17408);
    u16* VT = (u16*)(smem + 27648);
    float* plast = (float*)(smem + 37888);
    float* tqp = plast + 128;
    float* part = tqp + 512;
    const int dk = tid & 127, tq = tid >> 7;
    const float lb = 1.0f / (1.0f + __expf(p.lb_logits[512 + h * 128 + dk] - p.lb_logits[h * 128 + dk]));
    f32x4 S[8];
    { const float* ss = (const float*)(p.ws + W_SSTART) + (size_t)item * 16384;
#pragma unroll
      for (int blk = 0; blk < 8; ++blk)
#pragma unroll
          for (int j = 0; j < 4; ++j) S[blk][j] = ss[(16 * blk + 4 * g4 + j) * 128 + 16 * w + l15]; }
    const f32x4 gain = *(const f32x4*)(p.norm_hgrn + h * 128 + 16 * w + 4 * g4);
    u16* UB = (u16*)(p.ws + W_UA) + 256;
    u16 rf[8], rq[8], rv[8];
#pragma unroll
    for (int j = 0; j < 8; ++j) { const u16* zr = Z + (row0 + tq * 8 + j) * 8192 + h * 128 + dk; rf[j] = zr[C_FB]; rq[j] = zr[C_QB]; rv[j] = zr[C_IB]; }
    for (int ch = 0; ch < 8; ++ch) {
        float f[8], P[8], qv[8]; float prod = 1.0f;
#pragma unroll
        for (int j = 0; j < 8; ++j) { f[j] = lb + (1.0f - lb) * sigmoidf_(bf2f(rf[j])); prod *= f[j]; P[j] = prod; qv[j] = siluf_(bf2f(rq[j])); }
        tqp[tq * 128 + dk] = prod;
        *(u32x4*)(VT + dk * 40 + tq * 8) = (u32x4){(unsigned)rv[0] | ((unsigned)rv[1] << 16), (unsigned)rv[2] | ((unsigned)rv[3] << 16), (unsigned)rv[4] | ((unsigned)rv[5] << 16), (unsigned)rv[6] | ((unsigned)rv[7] << 16)};
        if (ch < 7) {
#pragma unroll
            for (int j = 0; j < 8; ++j) { const u16* zr = Z + (row0 + (ch + 1) * 32 + tq * 8 + j) * 8192 + h * 128 + dk; rf[j] = zr[C_FB]; rq[j] = zr[C_QB]; rv[j] = zr[C_IB]; } }
        __syncthreads();
        float pbase = 1.0f;
        for (int t2 = 0; t2 < tq; ++t2) pbase *= tqp[t2 * 128 + dk];
        const float ptot = tqp[dk] * tqp[128 + dk] * tqp[256 + dk] * tqp[384 + dk];
        float kt[8];
#pragma unroll
        for (int j = 0; j < 8; ++j) { const float Pj = pbase * P[j], ipj = 1.0f / Pj, kk = 1.0f - f[j];
            QT[(tq * 8 + j) * 136 + dk] = f2bf(qv[j] * Pj); KH[(tq * 8 + j) * 136 + dk] = f2bf(kk * ipj); kt[j] = kk * ptot * ipj; }
        *(u32x4*)(KT + dk * 40 + tq * 8) = (u32x4){pk2(kt[0], kt[1]), pk2(kt[2], kt[3]), pk2(kt[4], kt[5]), pk2(kt[6], kt[7])};
        if (tq == 0) plast[dk] = ptot;
        __syncthreads();
        f32x4 a00 = {0.f, 0.f, 0.f, 0.f}, a01 = a00, a11 = a00;
#pragma unroll
        for (int ks = 0; ks < 4; ++ks) { const int off = ks * 32 + g4 * 8;
            const bf16x8 k0 = *(const bf16x8*)(KH + l15 * 136 + off), k1 = *(const bf16x8*)(KH + (16 + l15) * 136 + off);
            const bf16x8 q0 = *(const bf16x8*)(QT + l15 * 136 + off), q1 = *(const bf16x8*)(QT + (16 + l15) * 136 + off);
            a00 = MFMA16(k0, q0, a00); a01 = MFMA16(k0, q1, a01); a11 = MFMA16(k1, q1, a11); }
#pragma unroll
        for (int j = 0; j < 4; ++j) { const bool ok = (4 * g4 + j) <= l15; a00[j] = ok ? a00[j] : 0.f; a11[j] = ok ? a11[j] : 0.f; }
        f32x4 o0 = {0.f, 0.f, 0.f, 0.f}, o1 = o0;
#pragma unroll
        for (int ks = 0; ks < 4; ++ks) { const bf16x8 sb = pack8(S[2 * ks], S[2 * ks + 1]);
            const u16* q0p = QT + l15 * 136 + ks * 32 + 4 * g4; const u16* q1p = q0p + 16 * 136;
            const u32x2 a = *(const u32x2*)q0p, bq = *(const u32x2*)(q0p + 16), c = *(const u32x2*)q1p, d = *(const u32x2*)(q1p + 16);
            o0 = MFMA16(sb, mk8(a[0], a[1], bq[0], bq[1]), o0); o1 = MFMA16(sb, mk8(c[0], c[1], d[0], d[1]), o1); }
        { const u16* vp = VT + (16 * w + l15) * 40 + 4 * g4; const u32x2 vlo = *(const u32x2*)vp, vhi = *(const u32x2*)(vp + 16);
          const bf16x8 va = mk8(vlo[0], vlo[1], vhi[0], vhi[1]); const f32x4 zz = {0.f, 0.f, 0.f, 0.f};
          o0 = MFMA16(va, pack8(a00, zz), o0); o1 = MFMA16(va, pack8(a01, a11), o1); }
        { const bf16x8 vb = *(const bf16x8*)(VT + (16 * w + l15) * 40 + g4 * 8);
#pragma unroll
          for (int blk = 0; blk < 8; ++blk) { const f32x4 pl = *(const f32x4*)(plast + 16 * blk + 4 * g4);
              S[blk] = MFMA16(*(const bf16x8*)(KT + (16 * blk + l15) * 40 + g4 * 8), vb, S[blk] * pl); } }
        { float q0 = o0[0] * o0[0] + o0[1] * o0[1] + o0[2] * o0[2] + o0[3] * o0[3], q1 = o1[0] * o1[0] + o1[1] * o1[1] + o1[2] * o1[2] + o1[3] * o1[3];
          q0 += __shfl_xor(q0, 16); q0 += __shfl_xor(q0, 32); q1 += __shfl_xor(q1, 16); q1 += __shfl_xor(q1, 32);
          if (g4 == 0) { part[w * 32 + l15] = q0; part[w * 32 + 16 + l15] = q1; } }
        __syncthreads();
#pragma unroll
        for (int tb = 0; tb < 2; ++tb) { const int t = 16 * tb + l15; float tot = 0.f;
#pragma unroll
            for (int ww = 0; ww < 8; ++ww) tot += part[ww * 32 + t];
            const float rs = rsqrtf(tot * (1.0f / 128.0f) + EPSN); const size_t row = row0 + ch * 32 + t; const f32x4 o = tb ? o1 : o0;
            const u32x2 gw = *(const u32x2*)(Z + row * 8192 + C_GB + h * 128 + 16 * w + 4 * g4);
            u32x2 wv = {pk2(o[0] * rs * gain[0] * siluf_(bflo(gw[0])), o[1] * rs * gain[1] * siluf_(bfhi(gw[0]))),
                        pk2(o[2] * rs * gain[2] * siluf_(bflo(gw[1])), o[3] * rs * gain[3] * siluf_(bfhi(gw[1])))};
            *(u32x2*)(UB + row * 1024 + h * 128 + 16 * w + 4 * g4) = wv; }
    }
    __syncthreads();
}

DI void dec_attn(const Params& p, char* smem, int item) {
    const u16* Z = (const u16*)(p.ws + W_Z);
    int b, src, h, part, np;
    const int tid = otid(), w = tid >> 6, lane = tid & 63, r = lane >> 4, c = lane & 15;
    if (item < 384) { b = item / 3; src = item - 3 * b; h = w & 3; part = w >> 2; np = 2; }
    else { const int q = item - 384; b = q >> 1; src = 3; h = 2 * (q & 1) + (w & 1); part = w >> 1; np = 4; }
    float* po = (float*)smem;
    float* ml = po + 512;
    const int dil = src == 0 ? 1 : (src == 1 ? 4 : 16), L = src == 0 ? 128 : (src == 1 ? 512 : 2048);
    const float* cw1 = p.c_w1; const float* cw2 = p.c_w2; const float* cw3 = p.c_w3; const float* cwm = p.c_mem;
    const float* cache = src == 0 ? cw1 + 0 : (src == 1 ? cw2 + 0 : (src == 2 ? cw3 + 0 : cwm + 0));
    const size_t brow = (size_t)b * (src == 3 ? 256 : L);
    const u16* zrow = Z + (size_t)(NTOK_P + b) * 8192;
    const int qcol = (src == 3 ? C_QM : C_QA + src * 256) + h * 64;
    const u32x2 qw = *(const u32x2*)(zrow + qcol + c * 4);
    const float q0 = bflo(qw[0]) * 0.125f, q1 = bfhi(qw[0]) * 0.125f, q2 = bflo(qw[1]) * 0.125f, q3 = bfhi(qw[1]) * 0.125f;
    const int j0 = part * 64;
    float m_run, l_run; float4 o = {0.f, 0.f, 0.f, 0.f};
    {
        float4 K[16], V[16];
#pragma unroll
        for (int it = 0; it < 16; ++it) { const int j = j0 + it * 4 + r; const int row = src == 3 ? j : L - dil * (j + 1);
            const float* kp = cache + (brow + row) * 512 + h * 64 + c * 4; K[it] = *(const float4*)kp; V[it] = *(const float4*)(kp + 256); }
        float s[16]; float mc = -1e30f;
#pragma unroll
        for (int it = 0; it < 16; ++it) { float d = K[it].x * q0 + K[it].y * q1 + K[it].z * q2 + K[it].w * q3;
            d += __shfl_xor(d, 1); d += __shfl_xor(d, 2); d += __shfl_xor(d, 4); d += __shfl_xor(d, 8); s[it] = d; mc = fmaxf(mc, d); }
        mc = fmaxf(mc, __shfl_xor(mc, 16)); mc = fmaxf(mc, __shfl_xor(mc, 32));
        m_run = mc; l_run = 0.f;
#pragma unroll
        for (int it = 0; it < 16; ++it) { const float pe = __expf(s[it] - mc); l_run += pe; o.x += pe * V[it].x; o.y += pe * V[it].y; o.z += pe * V[it].z; o.w += pe * V[it].w; }
    }
    l_run += __shfl_xor(l_run, 16); l_run += __shfl_xor(l_run, 32);
    o.x += __shfl_xor(o.x, 16); o.x += __shfl_xor(o.x, 32); o.y += __shfl_xor(o.y, 16); o.y += __shfl_xor(o.y, 32);
    o.z += __shfl_xor(o.z, 16); o.z += __shfl_xor(o.z, 32); o.w += __shfl_xor(o.w, 16); o.w += __shfl_xor(o.w, 32);
    if (r == 0) *(float4*)(po + w * 64 + c * 4) = o;
    if (lane == 0) { ml[w * 2] = m_run; ml[w * 2 + 1] = l_run; }
    __syncthreads();
    if (part == 0 && r == 0) {
        const int pstride = src == 3 ? 2 : 4;
        float sn = -1e30f; float4 vn = {0.f, 0.f, 0.f, 0.f};
        if (src < 3) { const u32x2 kw = *(const u32x2*)(zrow + C_KA + src * 256 + h * 64 + c * 4);
            float d = bflo(kw[0]) * q0 + bfhi(kw[0]) * q1 + bflo(kw[1]) * q2 + bfhi(kw[1]) * q3;
            d += __shfl_xor(d, 1); d += __shfl_xor(d, 2); d += __shfl_xor(d, 4); d += __shfl_xor(d, 8); sn = d;
            const u32x2 vw = *(const u32x2*)(zrow + C_VA + src * 256 + h * 64 + c * 4); vn = (float4){bflo(vw[0]), bfhi(vw[0]), bflo(vw[1]), bfhi(vw[1])}; }
        float M = sn;
        for (int k = 0; k < np; ++k) M = fmaxf(M, ml[(w + pstride * k) * 2]);
        const float wn = src < 3 ? __expf(sn - M) : 0.f;
        float l = wn; float4 ov = {wn * vn.x, wn * vn.y, wn * vn.z, wn * vn.w};
        for (int k = 0; k < np; ++k) { const int ww = w + pstride * k; const float wk = __expf(ml[ww * 2] - M); const float4 ok = *(const float4*)(po + ww * 64 + c * 4);
            l += wk * ml[ww * 2 + 1]; ov.x += wk * ok.x; ov.y += wk * ok.y; ov.z += wk * ok.z; ov.w += wk * ok.w; }
        const float inv = 1.0f / l; ov.x *= inv; ov.y *= inv; ov.z *= inv; ov.w *= inv; const size_t tok = NTOK_P + b;
        if (src < 3) { u32x2 wv = {pk2(ov.x, ov.y), pk2(ov.z, ov.w)}; *(u32x2*)((u16*)(p.ws + W_OA) + ((size_t)src * NTOK + tok) * 256 + h * 64 + c * 4) = wv;
            if (c == 0) ((float*)(p.ws + W_LSE))[((size_t)src * NTOK + tok) * 4 + h] = M + __logf(l); }
        else { const u32x2 gw = *(const u32x2*)(zrow + C_GM + h * 64 + c * 4);
            u32x2 wv = {pk2(ov.x * siluf_(bflo(gw[0])), ov.y * siluf_(bfhi(gw[0]))), pk2(ov.z * siluf_(bflo(gw[1])), ov.w * siluf_(bfhi(gw[1])))};
            *(u32x2*)((u16*)(p.ws + W_UA) + tok * 1024 + 768 + h * 64 + c * 4) = wv; } }
    __syncthreads();
}

DI void hg_step(const Params& p, char* smem, int item) {
    const u16* Z = (const u16*)(p.ws + W_Z);
    const int b = item >> 2, h = item & 3, tid = otid();
    const u16* zrow = Z + (size_t)(NTOK_P + b) * 8192;
    float* sf = (float*)smem; float* sq = sf + 128; float* sv = sq + 128; float* red = sv + 128;
    float* sss = red + 2048;
    if (tid < 128) { const int c = h * 128 + tid; const float lb = 1.0f / (1.0f + __expf(p.lb_logits[512 + c] - p.lb_logits[c]));
        sf[tid] = lb + (1.0f - lb) * sigmoidf_(bf2f(zrow[C_FB + c])); sq[tid] = siluf_(bf2f(zrow[C_QB + c])); }
    else if (tid < 256) sv[tid - 128] = bf2f(zrow[C_IB + h * 128 + tid - 128]);
    __syncthreads();
    const int c4 = (tid & 31) * 4, r0 = tid >> 5;
    const float* S0 = p.st_hgrn + (size_t)item * 16384; float* SO = p.out + O_HGS + (size_t)item * 16384;
    const float4 v4 = *(const float4*)(sv + c4);
    float4 oa = {0.f, 0.f, 0.f, 0.f};
#pragma unroll
    for (int i = 0; i < 8; ++i) { const int dkk = r0 + 16 * i; const float f = sf[dkk], k = 1.0f - f, q = sq[dkk];
        float4 s = *(const float4*)(S0 + dkk * 128 + c4);
        s.x = f * s.x + k * v4.x; s.y = f * s.y + k * v4.y; s.z = f * s.z + k * v4.z; s.w = f * s.w + k * v4.w;
        *(float4*)(SO + dkk * 128 + c4) = s;
        oa.x += s.x * q; oa.y += s.y * q; oa.z += s.z * q; oa.w += s.w * q; }
    *(float4*)(red + r0 * 128 + c4) = oa;
    __syncthreads();
    float o = 0.f;
    if (tid < 128) {
#pragma unroll
        for (int r = 0; r < 16; ++r) o += red[r * 128 + tid];
        const float q = wave_sum(o * o); if ((tid & 63) == 0) sss[tid >> 6] = q; }
    __syncthreads();
    if (tid < 128) { const float rs = rsqrtf((sss[0] + sss[1]) * (1.0f / 128.0f) + EPSN); const int c = h * 128 + tid;
        ((u16*)(p.ws + W_UA))[(size_t)(NTOK_P + b) * 1024 + 256 + c] = f2bf(o * rs * p.norm_hgrn[c] * siluf_(bf2f(zrow[C_GB + c]))); }
    __syncthreads();
}

DI void copy_rows_all(const Params& p) {
    const u16* Z = (const u16*)(p.ws + W_Z);
    const int tid = otid();
#pragma unroll
    for (int i = 0; i < 6; ++i) { size_t q = ((size_t)i * gridDim.x + blockIdx.x) * 512 + tid;
        const bool ok = q < 737280; if (!ok) q = 0;
        size_t oo; int g, L = 128; bool samp = false;
        if (q < 32768) { g = 0; L = 128; oo = O_W1P; } else if (q < 163840) { q -= 32768; g = 1; L = 512; oo = O_W2P; } else if (q < 688128) { q -= 163840; g = 2; L = 2048; oo = O_W3P; }
        else { q -= 688128; g = (int)(q >> 14); q &= 16383; samp = true; oo = g == 0 ? O_W1S : (g == 1 ? O_W2S : O_W3S); }
        const size_t e = q * 4; const int hd = (int)(e & 255), kv = (int)((e >> 8) & 1); size_t zr;
        if (samp) zr = NTOK_P + (e >> 9); else { const size_t bj = e >> 9; const int lg = g == 0 ? 7 : (g == 1 ? 9 : 11); const int bb = (int)(bj >> lg), j = (int)(bj & (size_t)(L - 1)); zr = (size_t)bb * 8192 + (8192 - L + j); }
        const u32x2 wv = *(const u32x2*)(Z + zr * 8192 + (kv ? C_VA : C_KA) + g * 256 + hd);
        if (ok) *(f32x4*)(p.out + oo + e) = (f32x4){bflo(wv[0]), bfhi(wv[0]), bflo(wv[1]), bfhi(wv[1])}; }
}

DI void phase_prefix(const Params& p) {
    copy_rows_all(p);
    const float* SLOC = (const float*)(p.ws + W_SLOC); const float* ASC = (const float*)(p.ws + W_ASC); float* SST = (float*)(p.ws + W_SSTART);
    const int tid = otid();
    for (int e = blockIdx.x * 512 + tid; e < 131072; e += gridDim.x * 512) { const int bh = e >> 14, idx = e & 16383, dk = idx >> 7; float s = 0.f;
        for (int s8 = 0; s8 < 4; ++s8) { float a[8], l[8];
#pragma unroll
            for (int j = 0; j < 8; ++j) { const int it = bh * 32 + s8 * 8 + j; a[j] = ASC[it * 128 + dk]; l[j] = SLOC[(size_t)it * 16384 + idx]; }
#pragma unroll
            for (int j = 0; j < 8; ++j) { const int it = bh * 32 + s8 * 8 + j; SST[(size_t)it * 16384 + idx] = s; s = a[j] * s + l[j]; } }
        p.out[O_HGP + e] = s; }
}
DI void attn_compute_win(const Params& p, char* smem, const AttnItem& a, const bf16x8 qf0, const bf16x8 qf1) {
    const int tid = otid(), w = tid >> 6, lane = tid & 63, l15 = lane & 15, g4 = lane >> 4;
    const u16* Ks = (const u16*)smem; const unsigned* VT = (const unsigned*)(smem + 36864);
    const int nb = a.nb, h = a.h, grp = a.grp;
    const int qi = 16 * w + l15; const size_t qrow = attn_qrow(a, qi);
    const u16* kbase = Ks + (w * 16 + l15) * 72 + g4 * 8;
    f32x4 s[9];
#pragma unroll
    for (int kg = 0; kg < 3; ++kg) { bf16x8 ka[4][2];
#pragma unroll
        for (int i = 0; i < 4; ++i) if (kg * 4 + i < 9) { const u16* kp_ = kbase + (kg * 4 + i) * 16 * 72; ka[i][0] = *(const bf16x8*)kp_; ka[i][1] = *(const bf16x8*)(kp_ + 32); }
        __builtin_amdgcn_sched_barrier(0);
#pragma unroll
        for (int i = 0; i < 4; ++i) if (kg * 4 + i < 9) { f32x4 acc = {0.f, 0.f, 0.f, 0.f}; acc = MFMA16(ka[i][0], qf0, acc); acc = MFMA16(ka[i][1], qf1, acc); s[kg * 4 + i] = acc; }
        __builtin_amdgcn_sched_barrier(0); }
    const float c1 = 0.125f * 1.4426950408889634f;
    float mx = -1e30f;
#pragma unroll
    for (int i = 0; i < 9; ++i) { const float bound = (i == 8 || (w + i) >= 8 || nb > 0) ? 3.0e38f : -1e30f;
#pragma unroll
        for (int j = 0; j < 4; ++j) { float v = fminf(s[i][j] * c1, bound);
            if (i == 0) v = (4 * g4 + j >= l15) ? v : -1e30f;
            if (i == 8) v = (4 * g4 + j <= l15) ? v : -1e30f;
            s[i][j] = v; mx = fmaxf(mx, v); } }
    mx = fmaxf(mx, __shfl_xor(mx, 16)); mx = fmaxf(mx, __shfl_xor(mx, 32));
    float l = 0.f;
#pragma unroll
    for (int i = 0; i < 9; ++i)
#pragma unroll
        for (int j = 0; j < 4; ++j) { const float e = __builtin_amdgcn_exp2f(s[i][j] - mx); s[i][j] = e; l += e; }
    l += __shfl_xor(l, 16); l += __shfl_xor(l, 32);
    f32x4 o[4];
#pragma unroll
    for (int db = 0; db < 4; ++db) o[db] = (f32x4){0.f, 0.f, 0.f, 0.f};
    const f32x4 zz = {0.f, 0.f, 0.f, 0.f};
#pragma unroll
    for (int j2 = 0; j2 < 5; ++j2) { unsigned vr[4][4];
#pragma unroll
        for (int db = 0; db < 4; ++db) { const unsigned* vp = VT + (db * 16 + l15) * 129 + 8 * (w + 2 * j2) + 2 * g4; vr[db][0] = vp[0]; vr[db][1] = vp[1];
            if (j2 < 4) { vr[db][2] = vp[8]; vr[db][3] = vp[9]; } else { vr[db][2] = vr[db][0]; vr[db][3] = vr[db][1]; } }
        const bf16x8 pf = j2 < 4 ? pack8(s[2 * j2], s[2 * j2 + 1]) : pack8(s[8], zz);
        __builtin_amdgcn_sched_barrier(0);
#pragma unroll
        for (int db = 0; db < 4; ++db) o[db] = MFMA16(mk8(vr[db][0], vr[db][1], vr[db][2], vr[db][3]), pf, o[db]);
        __builtin_amdgcn_sched_barrier(0); }
    const float inv = 1.0f / l;
    u16* OA = (u16*)(p.ws + W_OA); float* LSE = (float*)(p.ws + W_LSE); const size_t ro = (size_t)grp * NTOK + qrow;
#pragma unroll
    for (int db = 0; db < 4; ++db) { u32x2 wv = {pk2(o[db][0] * inv, o[db][1] * inv), pk2(o[db][2] * inv, o[db][3] * inv)};
        *(u32x2*)(OA + ro * 256 + h * 64 + db * 16 + 4 * g4) = wv; }
    if (g4 == 0) LSE[ro * 4 + h] = mx * 0.6931471805599453f + __logf(l);
}
constexpr int P2_HGL = 256, P2_AT = P2_HGL + 2048, P2_DA = P2_AT + 640, P2_HS = P2_DA + 512, P2_CP = P2_HS;
DI void phase_mix(const Params& p, char* smem, int sub) {
    const int G = (int)gridDim.x;
    if (sub == 31) { unsigned* cm = (unsigned*)(p.ws + W_CNT) + 64 * 65; const int q0 = (int)blockIdx.x - (G >= 192 ? 128 : 0);
        for (int q = q0; q >= 0 && q < 64; q += G) { const int rg = q >> 4, cb = q & 15;
            skinny_tile(p, 1, (const u16*)(p.ws + W_HM) + (size_t)rg * 128 * 1024, (const u16*)(p.ws + W_WMEMT), rg * 128, cb * 32); wg_publish(cm); } }
    int it = blockIdx.x;
    for (; it < P2_HGL; it += G) if (sub & 1) hg_local(p, smem, it);
    if (sub == 31) wg_consume((unsigned*)(p.ws + W_CNT) + 64 * 65, 64u);
    if (!(sub & 2)) { while (it < P2_AT) it += G; }
    if (it < P2_AT) {
        AttnRegs R; AttnItem a = attn_decode(it - P2_HGL); attn_load(p, a, R);
        for (;;) {
            attn_stage(smem, R); const bf16x8 q0 = R.q0, q1 = R.q1;
            __syncthreads();
            const int nx = it + G; const bool more = nx < P2_AT; AttnItem an = a;
            if (more) { an = attn_decode(nx - P2_HGL); attn_load(p, an, R); }
            if (a.is_mem) attn_compute(p, smem, a, q0, q1); else attn_compute_win(p, smem, a, q0, q1);
            __syncthreads();
            it = nx; a = an;
            if (!more) break;
        }
    }
    for (; it < P2_CP; it += G) {
        if (it < P2_DA) { if (sub & 4) dec_attn(p, smem, it - P2_AT); }
        else if (it < P2_HS) { if (sub & 8) hg_step(p, smem, it - P2_DA); }
    }
    if (sub == 31) {
        if (threadIdx.x == 0) { unsigned* cnt = (unsigned*)(p.ws + W_BAR); unsigned sp = 0;
            while (__hip_atomic_load(cnt, __ATOMIC_RELAXED, __HIP_MEMORY_SCOPE_AGENT) < (unsigned)P2_HGL) { __builtin_amdgcn_s_sleep(2); if (++sp > (1u << 20)) break; }
            __builtin_amdgcn_fence(__ATOMIC_ACQUIRE, "agent"); asm volatile("s_waitcnt vmcnt(0)" ::: "memory"); }
        __syncthreads();
        phase_prefix(p);
    }
}

DI void phase_hgout(const Params& p, char* smem) {
    for (int it = blockIdx.x; it < 256; it += gridDim.x) hg_out(p, smem, it);
    const u16* Z = (const u16*)(p.ws + W_Z); const u16* OA = (const u16*)(p.ws + W_OA); const float* LSE = (const float*)(p.ws + W_LSE); u16* UA = (u16*)(p.ws + W_UA);
    const int tid = otid();
    for (size_t q = (size_t)blockIdx.x * 512 + tid; q < (size_t)NTOK * 32; q += (size_t)gridDim.x * 512) { const size_t tok = q >> 5; const int c8 = (int)(q & 31) * 8, h = c8 >> 6;
        const float l0 = LSE[(0 * (size_t)NTOK + tok) * 4 + h], l1 = LSE[(1 * (size_t)NTOK + tok) * 4 + h], l2 = LSE[(2 * (size_t)NTOK + tok) * 4 + h];
        const float m = fmaxf(l0, fmaxf(l1, l2)); float w0 = __expf(l0 - m), w1 = __expf(l1 - m), w2 = __expf(l2 - m); const float inv = 1.0f / (w0 + w1 + w2); w0 *= inv; w1 *= inv; w2 *= inv;
        const u32x4 a = *(const u32x4*)(OA + (0 * (size_t)NTOK + tok) * 256 + c8), bq = *(const u32x4*)(OA + (1 * (size_t)NTOK + tok) * 256 + c8), c = *(const u32x4*)(OA + (2 * (size_t)NTOK + tok) * 256 + c8);
        const u32x4 gz = *(const u32x4*)(Z + tok * 8192 + C_GA + c8); u32x4 r;
#pragma unroll
        for (int j = 0; j < 4; ++j) { const float lo = (w0 * bflo(a[j]) + w1 * bflo(bq[j]) + w2 * bflo(c[j])) * siluf_(bflo(gz[j])), hi = (w0 * bfhi(a[j]) + w1 * bfhi(bq[j]) + w2 * bfhi(c[j])) * siluf_(bfhi(gz[j])); r[j] = pk2(lo, hi); }
        *(u32x4*)(UA + tok * 1024 + c8) = r; }
}
DI void phase_final(const Params& p) {
    const float* rss = (const float*)(p.ws + W_ROWSS); const u16* XN = (const u16*)(p.ws + W_MACC);
    const int tid = otid(); const size_t tot = (size_t)NTOK * 128, gs = (size_t)gridDim.x * 512;
    for (size_t q0 = (size_t)blockIdx.x * 512 + tid; q0 < tot; q0 += 4 * gs) { u32x4 v[4]; float4 g0[4], g1[4]; float rs[4];
#pragma unroll
        for (int j = 0; j < 4; ++j) { size_t q = q0 + j * gs; if (q >= tot) q = q0; const size_t row = q >> 7; const int c8 = (int)(q & 127) * 8;
            rs[j] = rss[row]; g0[j] = *(const float4*)(p.norm_final + c8); g1[j] = *(const float4*)(p.norm_final + c8 + 4); v[j] = *(const u32x4*)(XN + row * 1024 + c8); }
#pragma unroll
        for (int j = 0; j < 4; ++j) { const size_t q = q0 + j * gs; if (q < tot) { const size_t row = q >> 7; const int c8 = (int)(q & 127) * 8; const float r = rsqrtf(rs[j] * (1.0f / 1024.0f) + EPSN);
            float4 o0 = {bflo(v[j][0]) * r * g0[j].x, bfhi(v[j][0]) * r * g0[j].y, bflo(v[j][1]) * r * g0[j].z, bfhi(v[j][1]) * r * g0[j].w};
            float4 o1 = {bflo(v[j][2]) * r * g1[j].x, bfhi(v[j][2]) * r * g1[j].y, bflo(v[j][3]) * r * g1[j].z, bfhi(v[j][3]) * r * g1[j].w};
            *(float4*)(p.out + row * 1024 + c8) = o0; *(float4*)(p.out + row * 1024 + c8 + 4) = o1; } } }
}

#ifndef PHMASK
#define PHMASK 0xff
#endif
template <bool COOP>
__global__ __launch_bounds__(512, 2) void mega(Params p, int lo, int hi) {
    extern __shared__ __attribute__((aligned(16))) unsigned char shm[];
    char* smem = (char*)shm;
    PG8_LAS unsigned char* lds = (PG8_LAS unsigned char*)shm;
    const int G = (int)gridDim.x, c = (int)blockIdx.x;
#ifndef P2SUB
#define P2SUB 31
#endif
#ifndef XSYNC
#define XSYNC 0
#endif
#ifndef REP_MASK
#define REP_MASK 0
#endif
    XcdBarrier xb;
    if (COOP) {
        volatile PG8_LAS unsigned* st = (volatile PG8_LAS unsigned*)(lds + 131072);
        if (threadIdx.x == 0) { st[0] = 0u; st[1] = 0u; }
        __syncthreads();
        xb = xcd_barrier_post((unsigned*)(p.ws + W_BAR), st);
        if (lo < 0) cg::this_grid().sync();
        for (int i = 0; i < XSYNC; ++i) xcd_barrier(xb);
    }
    bool first = true;
    for (int pp = 2 * lo; pp < 2 * hi; ++pp) {
        const int ph = pp >> 1;
        if ((pp & 1) && !((REP_MASK >> ph) & 1)) continue;
        if (COOP && ph == 3) continue;
        if (COOP && ph == 7) continue;
        if (COOP && !first) xcd_barrier(xb);
        first = false;
        if (ph == 1 || ph == 5 || ph == 6) {
            GDesc d0, d1, d2, d3; MSched S; S.nsub = 1; S.has_extra = 0; S.ex_pm = 0; S.ex_pn = 0; S.ex_gi = 0;
            if (ph == 1) { d0 = GDesc{(const u16*)(p.ws + W_H), (const u16*)(p.ws + W_WINT), 1024, 0}; d1 = d0; d2 = d0; d3 = d0; S.so.init(NTOK_P, C_ZG, G, c); }
            else if (ph == 5) { const u16* H = (const u16*)(p.ws + W_H); const u16* WG = (const u16*)(p.ws + W_WINT) + (size_t)C_ZG * 1024;
                d0 = GDesc{H, WG, 1024, 7}; d1 = GDesc{H, WG + (size_t)1024 * 1024, 1024, 7}; d2 = GDesc{H, WG + (size_t)2048 * 1024, 1024, 7};
                d3 = GDesc{(const u16*)(p.ws + W_UA), (const u16*)(p.ws + W_WAT), 1024, 6}; S.so.init(NTOK_P, 1024, G, c); S.nsub = 4; }
            else { d0 = GDesc{(const u16*)(p.ws + W_MERGED), (const u16*)(p.ws + W_WOUTT), 1024, 5}; d1 = d0; d2 = d0; d3 = d0; S.so.init(NTOK_P, 1024, G, c); }
            S.nreg = c < S.so.nwg ? (S.so.nwg - c + G - 1) / G : 0;
            if (PHMASK & 2) { const size_t rsoff = (pp & 1) ? (W_SLOC - W_ROWSS) : 0; gemm_multi(lds, p, d0, d1, d2, d3, S, rsoff); phase_skinny(p, ph, rsoff); }
        }
        else if (ph == 0) { if (PHMASK & 1) phase_prep(p, smem); }
        else if (ph == 2) { if (PHMASK & 4) phase_mix(p, smem, (pp & 1) ? P2SUB : 31); }
        else if (ph == 3) { if (PHMASK & 8) phase_prefix(p); }
        else if (ph == 4) { if (PHMASK & 16) phase_hgout(p, smem); }
        else { if (PHMASK & 128) phase_final(p); }
    }
}

#ifndef MULTI_LAUNCH
#define MULTI_LAUNCH 0
#endif
extern "C" void kernel_launch(void* const* d_in, const int* in_sizes, int n_in, void* d_out, int out_size, void* d_ws, size_t ws_size, hipStream_t stream) {
    constexpr size_t kDynLds = 131072 + 16;
    static int grid_blocks = 0;
    if (!grid_blocks) {
        int dev = 0, cus = 0, per_cu = 0;
        hipGetDevice(&dev);
        hipDeviceGetAttribute(&cus, hipDeviceAttributeMultiprocessorCount, dev);
        hipFuncSetAttribute((const void*)mega<true>, hipFuncAttributeMaxDynamicSharedMemorySize, (int)kDynLds);
        hipFuncSetAttribute((const void*)mega<false>, hipFuncAttributeMaxDynamicSharedMemorySize, (int)kDynLds);
        hipOccupancyMaxActiveBlocksPerMultiprocessor(&per_cu, mega<true>, 512, kDynLds);
        if (per_cu < 1) per_cu = 1;
        if (per_cu > 1) per_cu = 1;
        grid_blocks = cus * per_cu;
        if (grid_blocks > 256) grid_blocks = 256;
    }
    Params p{};
    const float* const* in = (const float* const*)d_in;
    p.x_prompt = in[0]; p.x_sample = in[1]; p.mem_prompt = in[2]; p.c_w1 = in[3]; p.c_w2 = in[4]; p.c_w3 = in[5]; p.c_mem = in[6]; p.st_hgrn = in[7];
    p.norm_in = in[8]; p.w_in = in[9]; p.lb_logits = in[10]; p.norm_hgrn = in[11]; p.norm_mem = in[12]; p.w_mem_kv = in[13]; p.w_a = in[14]; p.w_b = in[15];
    p.w_m = in[16]; p.w_out = in[17]; p.norm_final = in[18];
    p.out = (float*)d_out; p.ws = (char*)d_ws;
#if MULTI_LAUNCH
    for (int ph = 0; ph < 8; ++ph) hipLaunchKernelGGL((mega<false>), dim3(grid_blocks), dim3(512), kDynLds, stream, p, ph, ph + 1);
#else
    int lo = 0, hi = 8;
    hipMemsetAsync((char*)d_ws + W_BAR, 0, BAR_ZERO_BYTES, stream);
    void* args[] = {&p, &lo, &hi};
    hipError_t e = hipLaunchCooperativeKernel((const void*)mega<true>, dim3(grid_blocks), dim3(512), args, kDynLds, stream);
    if (e != hipSuccess) fprintf(stderr, "cooperative launch failed: %s (grid %d)\n", hipGetErrorString(e), grid_blocks);
#endif
}
```

```cpp
#include <hip/hip_runtime.h>
#include <hip/hip_cooperative_groups.h>
#include <cstdio>
namespace cg = cooperative_groups;

#define DI __device__ __forceinline__
typedef unsigned short u16;
typedef float f2v __attribute__((ext_vector_type(2)));
typedef __bf16 b2v __attribute__((ext_vector_type(2)));
typedef short s16x4 __attribute__((ext_vector_type(4)));
typedef unsigned u32x2 __attribute__((ext_vector_type(2)));

DI unsigned pk2(float x, float y) { f2v v = {x, y}; b2v r = __builtin_convertvector(v, b2v); return __builtin_bit_cast(unsigned, r); }
DI u16 f2bf(float x) { __bf16 b = (__bf16)x; return __builtin_bit_cast(u16, b); }
DI float bf2f(u16 v) { return __uint_as_float(((unsigned)v) << 16); }
DI float bflo(unsigned w) { return __uint_as_float(w << 16); }
DI float bfhi(unsigned w) { return __uint_as_float(w & 0xffff0000u); }
DI float sigmoidf_(float x) { return __builtin_amdgcn_rcpf(1.0f + __expf(-x)); }
DI float siluf_(float x) { return x * __builtin_amdgcn_rcpf(1.0f + __expf(-x)); }

constexpr int DM = 1024, SEQ = 8192, NTOK_P = 16384, NTOK_S = 128, NTOK = 16512, MPAD = 16640, DIN = 8192;
constexpr int C_QA = 0, C_KA = 768, C_VA = 1536, C_GA = 2304, C_QB = 2560, C_FB = 3072, C_IB = 3584, C_GB = 4096, C_QM = 4608, C_GM = 4864, C_ZG = 5120;
constexpr float EPSN = 1e-6f;
constexpr size_t O_YP = 0, O_YS = 16777216, O_W1P = 16908288, O_W2P = 17039360, O_W3P = 17563648, O_MKV = 19660800, O_HGP = 19922944,
                 O_W1S = 20054016, O_W2S = 20119552, O_W3S = 20185088, O_HGS = 20250624;
constexpr size_t al256(size_t x) { return (x + 255) & ~(size_t)255; }
constexpr size_t W_H = 0;
constexpr size_t W_HM = W_H + al256((size_t)MPAD * 1024 * 2);
constexpr size_t W_WINT = W_HM + al256((size_t)512 * 1024 * 2);
constexpr size_t W_WMEMT = W_WINT + al256((size_t)8192 * 1024 * 2);
constexpr size_t W_WAT = W_WMEMT + al256((size_t)512 * 1024 * 2);
constexpr size_t W_WBT = W_WAT + al256((size_t)1024 * 1024 * 2);
constexpr size_t W_WMT = W_WBT + al256((size_t)1024 * 512 * 2);
constexpr size_t W_WOUTT = W_WMT + al256((size_t)1024 * 256 * 2);
constexpr size_t W_Z = W_WOUTT + al256((size_t)1024 * 1024 * 2);
constexpr size_t W_MEMKV = W_Z + al256((size_t)MPAD * 8192 * 2);
constexpr size_t W_OA = W_MEMKV + al256((size_t)512 * 512 * 2);
constexpr size_t W_LSE = W_OA + al256((size_t)3 * NTOK * 256 * 2);
constexpr size_t W_UA = W_LSE + al256((size_t)3 * NTOK * 4 * 4);
constexpr size_t W_UB = W_UA + al256((size_t)MPAD * 1024 * 2);
constexpr size_t W_UM = W_UB + al256((size_t)MPAD * 512 * 2);
constexpr size_t W_SLOC = W_UM + al256((size_t)MPAD * 256 * 2);
constexpr size_t W_ASC = W_SLOC + al256((size_t)256 * 16384 * 4);
constexpr size_t W_SSTART = W_ASC + al256((size_t)256 * 128 * 4);
constexpr size_t W_MACC = W_SSTART + al256((size_t)256 * 16384 * 4);
constexpr size_t W_MERGED = W_MACC + al256((size_t)MPAD * 1024 * 4);
constexpr size_t W_ROWSS = W_MERGED + al256((size_t)MPAD * 1024 * 2);
constexpr size_t W_BAR = W_ROWSS + al256((size_t)MPAD * 4);
constexpr size_t W_CNT = W_BAR + 16384;
constexpr size_t BAR_ZERO_BYTES = 16384 + 66 * 256;
constexpr size_t W_GSC = W_BAR + 36864;
constexpr size_t W_END = W_GSC + (size_t)256 * 3 * 131072;

struct Params {
    const float *x_prompt, *x_sample, *mem_prompt, *c_w1, *c_w2, *c_w3, *c_mem, *st_hgrn, *norm_in, *w_in, *lb_logits, *norm_hgrn, *norm_mem,
        *w_mem_kv, *w_a, *w_b, *w_m, *w_out, *norm_final;
    float* out;
    char* ws;
};

namespace pg8 {
#define PG8_LAS __attribute__((address_space(3)))
typedef unsigned short bf16_t;
typedef short bf16x8 __attribute__((ext_vector_type(8)));
typedef float f32x4 __attribute__((ext_vector_type(4)));
typedef unsigned u32x4 __attribute__((ext_vector_type(4)));
constexpr int BM = 256, BK = 64, HALF = 128, HTB = HALF * BK * 2  , STAGE_BYTES = 8 * HTB, NXCD = 8, WGM = 8;

__host__ __device__ __forceinline__ int lds_byte(int r, int c) { const int st = (r >> 4) * 2 + (c >> 5), rr = r & 15, cc = c & 31, ob = rr * 64 + cc * 2; return st * 1024 + (ob ^ (((ob >> 9) & 1) << 5)); }
__host__ __device__ __forceinline__ void stage_rc(int b, int& R, int& C) { const int st = b / 1024, sb = b % 1024, swz = sb ^ (((sb >> 9) & 1) << 5); R = (st >> 1) * 16 + swz / 64; C = (st & 1) * 32 + (swz % 64) / 2; }
__host__ __device__ __forceinline__ int perm32(int rho) { const int n = rho >> 4, i = rho & 15; return 8 * (i >> 2) + 4 * n + (i & 3); }

struct Unit { int pm, pn; };
struct Gemm { const bf16_t* A; const bf16_t* Bt; int M, N, K; };

struct StaticOrder {
    int nM, nN, nwg, G, c;
    __host__ __device__ void init(int M, int N, int G_, int c_) { nM = M / BM; nN = N / BM; nwg = nM * nN; G = G_; c = c_; }
    __host__ __device__ bool next(int i, Unit& u) const {
        const long L = (long)i * G + c; if (L >= nwg) return false;
        int wgid = (int)L; { const int q = nwg / NXCD, r = nwg % NXCD, xcd = wgid % NXCD, off = wgid / NXCD; wgid = (xcd < r ? xcd * (q + 1) : r * (q + 1) + (xcd - r) * q) + off; }
        const int nig = WGM * nN, gid = wgid / nig, fm = gid * WGM, gsz = (nM - fm) < WGM ? (nM - fm) : WGM;
        u.pm = fm + ((wgid % nig) % gsz); u.pn = (wgid % nig) / gsz; return true;
    }
    __device__ __forceinline__ void a_ready(const Unit&) const {}
    __device__ __forceinline__ void done(const Unit&) const {}
};
__device__ __forceinline__ unsigned cvt_pk_bf16(float lo, float hi) { unsigned r; asm volatile("v_cvt_pk_bf16_f32 %0, %1, %2" : "=v"(r) : "v"(lo), "v"(hi)); return r; }
template <class Epi, class Sched, bool STAMP = false>
__device__ __forceinline__ void gemm_phase(PG8_LAS unsigned char* lds, const Gemm g, const Sched& S, const Epi& E, unsigned long long* stamps) {
    const int tid = threadIdx.x, wid = __builtin_amdgcn_readfirstlane(tid >> 6), lane = tid & 63, wr = wid >> 2, wc = wid & 3, fr = lane & 15, fq = lane >> 4;
    const int K = g.K, nt = K / BK;
    int ts_lo = 0, ts_hi = 0, nts = 0; const unsigned long long rt_entry = STAMP ? (unsigned long long)wall_clock64() : 0ull;
#define PG8_STAMP() do { if (STAMP && wid == 0 && nts < 64) { const unsigned long long _c = (unsigned long long)clock64(); \
        ts_lo = (lane == nts) ? (int)(unsigned)_c : ts_lo; ts_hi = (lane == nts) ? (int)(unsigned)(_c >> 32) : ts_hi; ++nts; } } while (0)
    PG8_STAMP();
    unsigned voffA[2], voffB[2];
#pragma unroll
    for (int i = 0; i < 2; ++i) { int R, C; stage_rc(tid * 16 + i * 8192, R, C); const int Rb = Epi::PERM ? ((R & ~31) + perm32(R & 31)) : R;
        voffA[i] = (unsigned)(R * K + C) * 2u; voffB[i] = (unsigned)(Rb * K + C) * 2u; }
    const size_t kstep = (size_t)(BK * 2);
    const size_t hstep = (size_t)HALF * K * 2;
    const size_t tstep = 2 * hstep;
    const unsigned ldsw = (unsigned)wid * 1024u;
    const int aoff = lds_byte(wr * 64 + fr, fq * 8), boff = lds_byte(wc * 32 + fr, fq * 8);
#define PG8_SA(b, h) (((b) * 2 + (h)) * HTB)
#define PG8_SB(b, h) ((4 + (b) * 2 + (h)) * HTB)
#define PG8_STAGE(bufoff, gbase, voff) do { _Pragma("unroll") for (int _i = 0; _i < 2; ++_i) \
        __builtin_amdgcn_global_load_lds((const unsigned*)((const char*)(gbase) + (voff)[_i]), (PG8_LAS unsigned*)(lds + (bufoff) + ldsw + _i * 8192), 16, 0, 0); } while (0)
#define PG8_LDA(dst, b, h) do { _Pragma("unroll") for (int m = 0; m < 4; ++m) _Pragma("unroll") for (int k = 0; k < 2; ++k) dst[m][k] = *(const PG8_LAS bf16x8*)(lds + PG8_SA(b, h) + aoff + m * 2048 + k * 1024); } while (0)
#define PG8_LDB(dst, b, h) do { _Pragma("unroll") for (int n = 0; n < 2; ++n) _Pragma("unroll") for (int k = 0; k < 2; ++k) dst[n][k] = *(const PG8_LAS bf16x8*)(lds + PG8_SB(b, h) + boff + n * 2048 + k * 1024); } while (0)
#define PG8_MMA(ai, bj, At, Bt) do { __builtin_amdgcn_s_setprio(1); _Pragma("unroll") for (int m = 0; m < 4; ++m) _Pragma("unroll") for (int n = 0; n < 2; ++n) _Pragma("unroll") for (int k = 0; k < 2; ++k) \
        acc[ai][bj][m][n] = __builtin_amdgcn_mfma_f32_16x16x32_bf16(Bt[n][k], At[m][k], acc[ai][bj][m][n], 0, 0, 0); __builtin_amdgcn_s_setprio(0); } while (0)
#define PG8_WAIT_V(n) asm volatile("s_waitcnt vmcnt(" #n ")" ::: "memory")
#define PG8_WAIT_L(n) asm volatile("s_waitcnt lgkmcnt(" #n ")" ::: "memory")
#define PG8_BAR __builtin_amdgcn_s_barrier()
#define PG8_SCHED __builtin_amdgcn_sched_barrier(0)
    Unit cur, nxt; int ui = 0;
    if (!S.next(0, cur)) return;
    f32x4 acc[2][2][4][2];
#pragma unroll
    for (int a = 0; a < 2; ++a)
#pragma unroll
        for (int b = 0; b < 2; ++b)
#pragma unroll
            for (int m = 0; m < 4; ++m)
#pragma unroll
                for (int n = 0; n < 2; ++n) acc[a][b][m][n] = (f32x4){0.f, 0.f, 0.f, 0.f};
    bf16x8 At[4][2], B0[2][2], B1[2][2];
    const char* cA = (const char*)g.A + (size_t)cur.pm * tstep; const char* cB = (const char*)g.Bt + (size_t)cur.pn * tstep;
    S.a_ready(cur);
    PG8_STAGE(PG8_SB(0, 0), cB, voffB); PG8_STAGE(PG8_SA(0, 0), cA, voffA); PG8_STAGE(PG8_SB(0, 1), cB + hstep, voffB); PG8_STAGE(PG8_SA(0, 1), cA + hstep, voffA);
    if (wr == 1) PG8_BAR;
    PG8_WAIT_V(4); PG8_BAR;
    PG8_STAGE(PG8_SB(1, 0), cB + kstep, voffB); PG8_STAGE(PG8_SA(1, 0), cA + kstep, voffA); PG8_STAGE(PG8_SB(1, 1), cB + hstep + kstep, voffB);
    PG8_WAIT_V(6); PG8_BAR;
    PG8_STAMP();
    for (;;) {
        const bool has_next = S.next(ui + 1, nxt);
        const char* nA = has_next ? (const char*)g.A + (size_t)nxt.pm * tstep : cA; const char* nB = has_next ? (const char*)g.Bt + (size_t)nxt.pn * tstep : cB;
        for (int t = 0; t < nt; t += 2) {
            const bool last = (t == nt - 2);
            const char* a1 = cA + (size_t)(t + 1) * kstep;
            const char* a2 = last ? nA : cA + (size_t)(t + 2) * kstep; const char* b2 = last ? nB : cB + (size_t)(t + 2) * kstep;
            const char* a3 = a2 + kstep; const char* b3 = b2 + kstep;
            if (last && has_next) S.a_ready(nxt);
            PG8_LDB(B0, 0, 0); PG8_SCHED; PG8_LDA(At, 0, 0); PG8_STAGE(PG8_SA(1, 1), a1 + hstep, voffA);
            PG8_WAIT_L(8); PG8_BAR; PG8_WAIT_L(0); PG8_MMA(0, 0, At, B0); PG8_BAR; PG8_SCHED;
            PG8_LDB(B1, 0, 1); PG8_STAGE(PG8_SB(0, 0), b2, voffB);
            PG8_BAR; PG8_WAIT_L(0); PG8_MMA(0, 1, At, B1); PG8_BAR;
            PG8_LDA(At, 0, 1); PG8_STAGE(PG8_SA(0, 0), a2, voffA);
            PG8_BAR; PG8_WAIT_L(0); PG8_MMA(1, 0, At, B0); PG8_BAR; PG8_SCHED;
            PG8_STAGE(PG8_SB(0, 1), b2 + hstep, voffB);
            PG8_WAIT_V(6); PG8_BAR; PG8_MMA(1, 1, At, B1); PG8_BAR;
            PG8_LDB(B0, 1, 0); PG8_SCHED; PG8_LDA(At, 1, 0); PG8_STAGE(PG8_SA(0, 1), a2 + hstep, voffA);
            PG8_WAIT_L(8); PG8_BAR; PG8_WAIT_L(0); PG8_MMA(0, 0, At, B0); PG8_BAR; PG8_SCHED;
            PG8_LDB(B1, 1, 1); PG8_STAGE(PG8_SB(1, 0), b3, voffB);
            PG8_BAR; PG8_WAIT_L(0); PG8_MMA(0, 1, At, B1); PG8_BAR;
            PG8_LDA(At, 1, 1); PG8_STAGE(PG8_SA(1, 0), a3, voffA);
            PG8_BAR; PG8_WAIT_L(0); PG8_MMA(1, 0, At, B0); PG8_BAR; PG8_SCHED;
            PG8_STAGE(PG8_SB(1, 1), b3 + hstep, voffB);
            PG8_WAIT_V(6); PG8_BAR; PG8_MMA(1, 1, At, B1); PG8_BAR;
        }
        PG8_STAMP();
        if constexpr (!Epi::AFTER_DRAIN) { E(acc, cur, wr, wc, fr, fq); S.done(cur); }
        PG8_STAMP();
        if (!has_next) break;
#pragma unroll
        for (int a = 0; a < 2; ++a)
#pragma unroll
            for (int b = 0; b < 2; ++b)
#pragma unroll
                for (int m = 0; m < 4; ++m)
#pragma unroll
                    for (int n = 0; n < 2; ++n) acc[a][b][m][n] = (f32x4){0.f, 0.f, 0.f, 0.f};
        cur = nxt; cA = nA; cB = nB; ++ui;
    }
    PG8_WAIT_V(0);
    if (wr == 0) PG8_BAR;
    PG8_BAR;
    if constexpr (Epi::AFTER_DRAIN) { E.fused(acc, cur, wr, wc, fr, fq, lds, wid, lane); S.done(cur); }
    PG8_STAMP();
    if (STAMP && wid == 0) { stamps[lane] = lane < nts ? (((unsigned long long)(unsigned)ts_hi << 32) | (unsigned)ts_lo) : 0ull;
        if (lane == 62) stamps[62] = rt_entry; if (lane == 63) stamps[63] = (unsigned long long)wall_clock64(); }
#undef PG8_STAMP
#undef PG8_SA
#undef PG8_SB
#undef PG8_STAGE
#undef PG8_LDA
#undef PG8_LDB
#undef PG8_MMA
#undef PG8_WAIT_V
#undef PG8_WAIT_L
#undef PG8_BAR
#undef PG8_SCHED
}
}
#define XB_TMO      128
#define XB_XCNT(j)  (256  + 64 * (j))
#define XB_XSUB(j)  (1280 + 64 * (j))
#define XB_XGEN(j)  (2304 + 64 * (j))
#define XB_TOP      3328
#define XB_TOPGEN   3392
#define XCD_BAR_WORDS 3456
#define XB_SPIN_CAP (1u << 18)

__device__ __forceinline__ unsigned xb_ld(unsigned* p)              { return __hip_atomic_load(p, __ATOMIC_RELAXED, __HIP_MEMORY_SCOPE_AGENT); }
__device__ __forceinline__ unsigned xb_add(unsigned* p, unsigned v) { return __hip_atomic_fetch_add(p, v, __ATOMIC_RELAXED, __HIP_MEMORY_SCOPE_AGENT); }
__device__ __forceinline__ unsigned xb_xcc_id() { return (unsigned)__builtin_amdgcn_s_getreg((3 << 11) | 20) & 0xFu; }
#define XB_SPIN(cond, bar) do { unsigned _sp = 0; while (cond) { __builtin_amdgcn_s_sleep(1); \
    if ((++_sp & 255u) == 0u) { if (xb_ld(&(bar)[XB_TMO])) break; if (_sp > XB_SPIN_CAP) { atomicAdd(&(bar)[XB_TMO], 1u); break; } } } } while (0)

struct XcdBarrier {
    unsigned* bar; unsigned x;
    volatile PG8_LAS unsigned* st;
};

__device__ __forceinline__ XcdBarrier xcd_barrier_post(unsigned* bar, volatile PG8_LAS unsigned* st) {
    XcdBarrier b; b.bar = bar; b.x = xb_xcc_id(); b.st = st;
    if (threadIdx.x == 0) (void)xb_add(&bar[XB_XCNT(b.x)], 1u);
    return b;
}
__device__ __forceinline__ void xcd_barrier_complete(unsigned* bar, unsigned x, unsigned& nloc, unsigned& nx) {
    const unsigned G = gridDim.x * gridDim.y * gridDim.z;
    unsigned sum, cnt, mine, sp = 0u;
    for (;;) {
        sum = 0u; cnt = 0u; mine = 0u;
#pragma unroll
        for (unsigned j = 0; j < 16; ++j) { const unsigned c = xb_ld(&bar[XB_XCNT(j)]); sum += c; cnt += (c > 0u) ? 1u : 0u; mine = (j == x) ? c : mine; }
        if (sum == G) break;
        __builtin_amdgcn_s_sleep(1);
        if ((++sp & 255u) == 0u) { if (xb_ld(&bar[XB_TMO])) break; if (sp > XB_SPIN_CAP) { atomicAdd(&bar[XB_TMO], 1u); break; } }
    }
    nloc = mine > 0u ? mine : 1u; nx = cnt > 0u ? cnt : 1u;
}

__device__ __forceinline__ void xcd_barrier(const XcdBarrier& b) {
    asm volatile("s_waitcnt vmcnt(0)" ::: "memory");
    __syncthreads();
    if (threadIdx.x == 0) {
        unsigned* bar = b.bar;
        __builtin_amdgcn_s_waitcnt(0);
        unsigned nloc = b.st[0], nx = b.st[1];
        if (nloc == 0u) { xcd_barrier_complete(bar, b.x, nloc, nx); b.st[0] = nloc; b.st[1] = nx; }
        const unsigned old = xb_add(&bar[XB_XSUB(b.x)], 1u);
        const unsigned gen = old / nloc;
        if (old + 1u == (gen + 1u) * nloc) {
            __builtin_amdgcn_fence(__ATOMIC_RELEASE, "agent");
            asm volatile("s_waitcnt vmcnt(0)" ::: "memory");
            const unsigned og = xb_add(&bar[XB_TOP], 1u);
            const unsigned tg = og / nx;
            if (og + 1u == (tg + 1u) * nx) xb_add(&bar[XB_TOPGEN], 1u);
            else XB_SPIN(xb_ld(&bar[XB_TOPGEN]) == tg, bar);
            __builtin_amdgcn_fence(__ATOMIC_ACQUIRE, "agent");
            xb_add(&bar[XB_XGEN(b.x)], 1u);
            asm volatile("s_waitcnt vmcnt(0)" ::: "memory");
        } else {
            XB_SPIN(xb_ld(&bar[XB_XGEN(b.x)]) == gen, bar);
            __builtin_amdgcn_fence(__ATOMIC_ACQUIRE, "agent");
            asm volatile("s_waitcnt vmcnt(0)" ::: "memory");
        }
    }
    __syncthreads();
}

using pg8::bf16x8; using pg8::f32x4; using pg8::u32x4;
#define MFMA16(a, b, c) __builtin_amdgcn_mfma_f32_16x16x32_bf16((a), (b), (c), 0, 0, 0)
DI int otid() { int t = threadIdx.x; asm volatile("" : "+v"(t)); return t; }
DI float wave_sum(float v) { for (int o = 32; o >= 1; o >>= 1) v += __shfl_xor(v, o); return v; }
DI float wave_max(float v) { for (int o = 32; o >= 1; o >>= 1) v = fmaxf(v, __shfl_xor(v, o)); return v; }
DI bf16x8 mk8(unsigned a, unsigned b, unsigned c, unsigned d) { u32x4 w = {a, b, c, d}; return __builtin_bit_cast(bf16x8, w); }
DI bf16x8 pack8(const f32x4& a, const f32x4& b) { return mk8(pk2(a[0], a[1]), pk2(a[2], a[3]), pk2(b[0], b[1]), pk2(b[2], b[3])); }

DI void norm_row(const float* src, const float* gain, u16* dst, int lane) {
    float4 v[4]; float ss = 0.f;
#pragma unroll
    for (int i = 0; i < 4; ++i) { v[i] = ((const float4*)src)[lane + 64 * i]; ss += v[i].x * v[i].x + v[i].y * v[i].y + v[i].z * v[i].z + v[i].w * v[i].w; }
    ss = wave_sum(ss);
    const float rs = rsqrtf(ss * (1.0f / 1024.0f) + EPSN);
#pragma unroll
    for (int i = 0; i < 4; ++i) { const float4 g = ((const float4*)gain)[lane + 64 * i];
        u32x2 w = {pk2(v[i].x * rs * g.x, v[i].y * rs * g.y), pk2(v[i].z * rs * g.z, v[i].w * rs * g.w)};
        *(u32x2*)(dst + (size_t)(lane + 64 * i) * 4) = w; }
}
struct TJob { const float* src; u16* dst; int K, N, tk, tn, ldk, koff; };
DI TJob tjob(const Params& p, int j) {
    TJob t;
    if (j < 2048) t = TJob{p.w_in, (u16*)(p.ws + W_WINT), 1024, 8192, j & 15, j >> 4, 1024, 0};
    else if (j < 2176) { const int q = j - 2048; t = TJob{p.w_mem_kv, (u16*)(p.ws + W_WMEMT), 1024, 512, q & 15, q >> 4, 1024, 0}; }
    else if (j < 2240) { const int q = j - 2176; t = TJob{p.w_a, (u16*)(p.ws + W_WAT), 256, 1024, q & 3, q >> 2, 1024, 0}; }
    else if (j < 2368) { const int q = j - 2240; t = TJob{p.w_b, (u16*)(p.ws + W_WAT), 512, 1024, q & 7, q >> 3, 1024, 256}; }
    else if (j < 2432) { const int q = j - 2368; t = TJob{p.w_m, (u16*)(p.ws + W_WAT), 256, 1024, q & 3, q >> 2, 1024, 768}; }
    else { const int q = j - 2432; t = TJob{p.w_out, (u16*)(p.ws + W_WOUTT), 1024, 1024, q & 15, q >> 4, 1024, 0}; }
    return t;
}
DI void tload(const TJob& t, int tid, float4 (&v)[2]) {
    const int r = tid >> 4, c4 = (tid & 15) * 4;
#pragma unroll
    for (int it = 0; it < 2; ++it) v[it] = *(const float4*)(t.src + (size_t)(t.tk * 64 + r + 32 * it) * t.N + t.tn * 64 + c4);
}
DI void phase_prep(const Params& p, char* smem) {
    const int tid = otid(), wid = tid >> 6, lane = tid & 63;
    u16* H = (u16*)(p.ws + W_H); u16* HM = (u16*)(p.ws + W_HM);
    float* t = (float*)smem;
    { int j = blockIdx.x; const int G = gridDim.x;
      if (j < 2688) { TJob cur = tjob(p, j); float4 v[2]; tload(cur, tid, v);
        for (;;) {
            { const int r = tid >> 4, c4 = (tid & 15) * 4;
#pragma unroll
              for (int it = 0; it < 2; ++it) { float* d = t + (r + 32 * it) * 65 + c4; d[0] = v[it].x; d[1] = v[it].y; d[2] = v[it].z; d[3] = v[it].w; } }
            __syncthreads();
            const int jn = j + G; const bool more = jn < 2688; TJob nx = cur;
            if (more) { nx = tjob(p, jn); tload(nx, tid, v); }
            { const int n = tid >> 3, ks = (tid & 7) * 8; float a[8];
#pragma unroll
              for (int i = 0; i < 8; ++i) a[i] = t[(ks + i) * 65 + n];
              u32x4 w = {pk2(a[0], a[1]), pk2(a[2], a[3]), pk2(a[4], a[5]), pk2(a[6], a[7])};
              *(u32x4*)(cur.dst + (size_t)(cur.tn * 64 + n) * cur.ldk + cur.koff + cur.tk * 64 + ks) = w; }
            __syncthreads();
            if (!more) break;
            j = jn; cur = nx;
        } } }
    { const int nw = gridDim.x * 8;
      for (int r = blockIdx.x * 8 + wid; r < NTOK + 512; r += 2 * nw) {
        const int r2 = r + nw; const bool two = r2 < NTOK + 512;
        const float* s0; const float* g0; u16* d0; const float* s1; const float* g1; u16* d1;
        if (r < NTOK_P) { s0 = p.x_prompt + (size_t)r * 1024; g0 = p.norm_in; d0 = H + (size_t)r * 1024; }
        else if (r < NTOK) { s0 = p.x_sample + (size_t)(r - NTOK_P) * 1024; g0 = p.norm_in; d0 = H + (size_t)r * 1024; }
        else { s0 = p.mem_prompt + (size_t)(r - NTOK) * 1024; g0 = p.norm_mem; d0 = HM + (size_t)(r - NTOK) * 1024; }
        const int rr = two ? r2 : r;
        if (rr < NTOK_P) { s1 = p.x_prompt + (size_t)rr * 1024; g1 = p.norm_in; d1 = H + (size_t)rr * 1024; }
        else if (rr < NTOK) { s1 = p.x_sample + (size_t)(rr - NTOK_P) * 1024; g1 = p.norm_in; d1 = H + (size_t)rr * 1024; }
        else { s1 = p.mem_prompt + (size_t)(rr - NTOK) * 1024; g1 = p.norm_mem; d1 = HM + (size_t)(rr - NTOK) * 1024; }
        float4 va[4], vb[4]; float sa = 0.f, sb = 0.f;
#pragma unroll
        for (int i = 0; i < 4; ++i) { va[i] = ((const float4*)s0)[lane + 64 * i]; vb[i] = ((const float4*)s1)[lane + 64 * i]; }
#pragma unroll
        for (int i = 0; i < 4; ++i) { sa += va[i].x * va[i].x + va[i].y * va[i].y + va[i].z * va[i].z + va[i].w * va[i].w; sb += vb[i].x * vb[i].x + vb[i].y * vb[i].y + vb[i].z * vb[i].z + vb[i].w * vb[i].w; }
        sa = wave_sum(sa); sb = wave_sum(sb);
        const float ra = rsqrtf(sa * (1.0f / 1024.0f) + EPSN), rb = rsqrtf(sb * (1.0f / 1024.0f) + EPSN);
#pragma unroll
        for (int i = 0; i < 4; ++i) { const float4 ga = ((const float4*)g0)[lane + 64 * i], gb = ((const float4*)g1)[lane + 64 * i];
            u32x2 wa = {pk2(va[i].x * ra * ga.x, va[i].y * ra * ga.y), pk2(va[i].z * ra * ga.z, va[i].w * ra * ga.w)};
            u32x2 wb = {pk2(vb[i].x * rb * gb.x, vb[i].y * rb * gb.y), pk2(vb[i].z * rb * gb.z, vb[i].w * rb * gb.w)};
            *(u32x2*)(d0 + (size_t)(lane + 64 * i) * 4) = wa; if (two) *(u32x2*)(d1 + (size_t)(lane + 64 * i) * 4) = wb; }
      } }
    { const size_t g = (size_t)blockIdx.x * 512 + tid, gs = (size_t)gridDim.x * 512;
      float* rs = (float*)(p.ws + W_ROWSS); for (size_t i = g; i < (size_t)MPAD; i += gs) rs[i] = 0.f; }
}

struct GDesc { const u16* A; const u16* Bt; int K; int mode; };
struct MUnit { int pm, pn, gi; };
struct MSched {
    pg8::StaticOrder so; int nsub, nreg, ex_pm, ex_pn, ex_gi, has_extra;
    DI bool next(int i, MUnit& u) const {
        const int ti = nsub == 4 ? (i >> 2) : i, gi = nsub == 4 ? (i & 3) : 0;
        pg8::Unit t;
        if (so.next(ti, t)) { u.pm = t.pm; u.pn = t.pn; u.gi = gi; return true; }
        if (has_extra && ti == nreg) { u.pm = ex_pm; u.pn = ex_pn; u.gi = ex_gi; return true; }
        return false;
    }
};
DI void epi_all(const Params& p, int mode, const f32x4 (&acc)[2][2][4][2], const MUnit& u, size_t rsoff) {
    const int tq_ = otid(), wq_ = tq_ >> 6, wr = wq_ >> 2, wc = wq_ & 3, fr = tq_ & 15, fq = (tq_ >> 4) & 3;
    const int row0 = u.pm * 256 + wr * 64 + fr, col0 = u.pn * 256 + wc * 32 + 8 * fq;
    if (mode == 0) { u16* O = (u16*)(p.ws + W_Z);
#pragma unroll
        for (int ai = 0; ai < 2; ++ai)
#pragma unroll
            for (int m = 0; m < 4; ++m) { u16* rowp = O + (size_t)(row0 + ai * 128 + m * 16) * DIN + col0;
#pragma unroll
                for (int bj = 0; bj < 2; ++bj) *(bf16x8*)(rowp + bj * 128) = pack8(acc[ai][bj][m][0], acc[ai][bj][m][1]);
                asm volatile("" ::: "memory"); }
    } else if (mode == 1) { u16* O = (u16*)(p.ws + W_MEMKV); float* F = p.out + O_MKV;
#pragma unroll
        for (int ai = 0; ai < 2; ++ai)
#pragma unroll
            for (int m = 0; m < 4; ++m) { const size_t ro = (size_t)(row0 + ai * 128 + m * 16) * 512 + col0;
#pragma unroll
                for (int bj = 0; bj < 2; ++bj) { *(bf16x8*)(O + ro + bj * 128) = pack8(acc[ai][bj][m][0], acc[ai][bj][m][1]);
                    *(f32x4*)(F + ro + bj * 128) = acc[ai][bj][m][0]; *(f32x4*)(F + ro + bj * 128 + 4) = acc[ai][bj][m][1]; }
                asm volatile("" ::: "memory"); }
    } else if (mode == 7) {
        u16* G = (u16*)(p.ws + W_GSC) + ((size_t)blockIdx.x * 3 + u.gi) * 65536 + (size_t)(wr * 64 + fr) * 256 + wc * 32 + 8 * fq;
#pragma unroll
        for (int ai = 0; ai < 2; ++ai)
#pragma unroll
            for (int m = 0; m < 4; ++m) {
#pragma unroll
                for (int bj = 0; bj < 2; ++bj) { f32x4 t0, t1;
#pragma unroll
                    for (int j = 0; j < 4; ++j) { t0[j] = 1.0f + __expf(-acc[ai][bj][m][0][j]); t1[j] = 1.0f + __expf(-acc[ai][bj][m][1][j]); }
                    *(bf16x8*)(G + (ai * 128 + m * 16) * 256 + bj * 128) = pack8(t0, t1); }
                asm volatile("" ::: "memory"); }
    } else if (mode == 6) {
        const u16* GS = (const u16*)(p.ws + W_GSC) + ((size_t)blockIdx.x * 3 + 2) * 65536 + (size_t)(wr * 64 + fr) * 256 + wc * 32 + 8 * fq; u16* merged = (u16*)(p.ws + W_MERGED);
#pragma unroll
        for (int ai = 0; ai < 2; ++ai) { u32x4 ga[4][2];
#pragma unroll
            for (int m = 0; m < 4; ++m)
#pragma unroll
                for (int bj = 0; bj < 2; ++bj) ga[m][bj] = *(const u32x4*)(GS + (ai * 128 + m * 16) * 256 + bj * 128);
#pragma unroll
            for (int m = 0; m < 4; ++m)
#pragma unroll
                for (int bj = 0; bj < 2; ++bj) { float f[8];
#pragma unroll
                    for (int j = 0; j < 4; ++j) { f[2 * j] = __builtin_amdgcn_rcpf(bflo(ga[m][bj][j])); f[2 * j + 1] = __builtin_amdgcn_rcpf(bfhi(ga[m][bj][j])); }
                    const f32x4 r0 = acc[ai][bj][m][0] * (f32x4){f[0], f[1], f[2], f[3]}, r1 = acc[ai][bj][m][1] * (f32x4){f[4], f[5], f[6], f[7]};
                    *(bf16x8*)(merged + (size_t)(row0 + ai * 128 + m * 16) * 1024 + col0 + bj * 128) = pack8(r0, r1); }
            asm volatile("" ::: "memory"); }
    } else { float* rowss = (float*)(p.ws + W_ROWSS + rsoff);
#pragma unroll
        for (int pr = 0; pr < 4; ++pr) { f32x4 xv[2][2][2];
#pragma unroll
            for (int q = 0; q < 2; ++q) { const int am = pr * 2 + q, ai = am >> 2, m = am & 3; const int row = row0 + ai * 128 + m * 16;
                const float* xr = row < NTOK_P ? p.x_prompt + (size_t)row * 1024 : p.x_sample + (size_t)(row - NTOK_P) * 1024;
#pragma unroll
                for (int bj = 0; bj < 2; ++bj)
#pragma unroll
                    for (int n = 0; n < 2; ++n) xv[q][bj][n] = *(const f32x4*)(xr + col0 + bj * 128 + n * 4); }
#pragma unroll
            for (int q = 0; q < 2; ++q) { const int am = pr * 2 + q, ai = am >> 2, m = am & 3; const int row = row0 + ai * 128 + m * 16; u16* orow = (u16*)(p.ws + W_MACC) + (size_t)row * 1024; float ss = 0.f;
#pragma unroll
                for (int bj = 0; bj < 2; ++bj)
#pragma unroll
                    for (int n = 0; n < 2; ++n) { const f32x4 r = xv[q][bj][n] + acc[ai][bj][m][n]; u32x2 wv = {pk2(r[0], r[1]), pk2(r[2], r[3])}; *(u32x2*)(orow + col0 + bj * 128 + n * 4) = wv; ss += r[0] * r[0] + r[1] * r[1] + r[2] * r[2] + r[3] * r[3]; }
                ss += __shfl_xor(ss, 16); ss += __shfl_xor(ss, 32);
                if (fq == 0) atomicAdd(rowss + row, ss); }
            asm volatile("" ::: "memory"); }
    }
}
DI void epi_fused(const Params& p, PG8_LAS unsigned char* lds, f32x4 (&acc)[2][2][4][2], const MUnit& u, size_t rsoff) {
    const int tq_ = otid(), wq_ = tq_ >> 6, wr = wq_ >> 2, wc = wq_ & 3, fr = tq_ & 15, fq = (tq_ >> 4) & 3;
    const int row0 = u.pm * 256 + wr * 64 + fr, col0 = u.pn * 256 + wc * 32 + 8 * fq;
    float* rowss = (float*)(p.ws + W_ROWSS + rsoff);
    unsigned* cnt = (unsigned*)(p.ws + W_CNT) + 64 * u.pm;
#pragma unroll
    for (int pr = 0; pr < 4; ++pr) { f32x4 xv[2][2][2];
#pragma unroll
        for (int q = 0; q < 2; ++q) { const int am = pr * 2 + q, ai = am >> 2, m = am & 3; const float* xr = p.x_prompt + (size_t)(row0 + ai * 128 + m * 16) * 1024;
#pragma unroll
            for (int bj = 0; bj < 2; ++bj)
#pragma unroll
                for (int n = 0; n < 2; ++n) xv[q][bj][n] = *(const f32x4*)(xr + col0 + bj * 128 + n * 4); }
#pragma unroll
        for (int q = 0; q < 2; ++q) { const int am = pr * 2 + q, ai = am >> 2, m = am & 3; float ss = 0.f;
#pragma unroll
            for (int bj = 0; bj < 2; ++bj)
#pragma unroll
                for (int n = 0; n < 2; ++n) { const f32x4 r = xv[q][bj][n] + acc[ai][bj][m][n]; acc[ai][bj][m][n] = r; ss += r[0] * r[0] + r[1] * r[1] + r[2] * r[2] + r[3] * r[3]; }
            ss += __shfl_xor(ss, 16); ss += __shfl_xor(ss, 32);
            if (fq == 0) atomicAdd(rowss + row0 + ai * 128 + m * 16, ss); }
        asm volatile("" ::: "memory"); }
    asm volatile("s_waitcnt vmcnt(0)" ::: "memory");
    __syncthreads();
    if (tq_ == 0) { __hip_atomic_fetch_add(cnt, 1u, __ATOMIC_RELAXED, __HIP_MEMORY_SCOPE_AGENT); unsigned sp = 0;
        while (__hip_atomic_load(cnt, __ATOMIC_RELAXED, __HIP_MEMORY_SCOPE_AGENT) < 4u) { __builtin_amdgcn_s_sleep(1); if (++sp > (1u << 20)) break; } }
    __syncthreads();
    PG8_LAS float* S = (PG8_LAS float*)lds;
    if (tq_ < 256) { const unsigned tb = __hip_atomic_load((unsigned*)(rowss + u.pm * 256 + tq_), __ATOMIC_RELAXED, __HIP_MEMORY_SCOPE_AGENT); S[tq_] = rsqrtf(__uint_as_float(tb) * (1.0f / 1024.0f) + EPSN); }
    __syncthreads();
    f32x4 gn[2][2];
#pragma unroll
    for (int bj = 0; bj < 2; ++bj)
#pragma unroll
        for (int n = 0; n < 2; ++n) gn[bj][n] = *(const f32x4*)(p.norm_final + col0 + bj * 128 + n * 4);
#pragma unroll
    for (int ai = 0; ai < 2; ++ai)
#pragma unroll
        for (int m = 0; m < 4; ++m) { const float rs = S[wr * 64 + fr + ai * 128 + m * 16]; float* orow = p.out + (size_t)(row0 + ai * 128 + m * 16) * 1024 + col0;
#pragma unroll
            for (int bj = 0; bj < 2; ++bj)
#pragma unroll
                for (int n = 0; n < 2; ++n) *(f32x4*)(orow + bj * 128 + n * 4) = acc[ai][bj][m][n] * rs * gn[bj][n]; }
}
DI void gate_scale(const Params& p, f32x4 (&acc)[2][2][4][2], const MUnit& u, int which) {
    const int tq_ = otid(), wq_ = tq_ >> 6, wr = wq_ >> 2, wc = wq_ & 3, fr = tq_ & 15, fq = (tq_ >> 4) & 3;
    const int row0 = u.pm * 256 + wr * 64 + fr, col0 = u.pn * 256 + wc * 32 + 8 * fq;
    const u16* GS = (const u16*)(p.ws + W_GSC) + ((size_t)blockIdx.x * 3 + which) * 65536 + (size_t)(wr * 64 + fr) * 256 + wc * 32 + 8 * fq;
#pragma unroll
    for (int pr = 0; pr < 4; ++pr) { u32x4 ga[2][2], gb[2][2];
#pragma unroll
        for (int q = 0; q < 2; ++q) { const int am = pr * 2 + q, ai = am >> 2, m = am & 3;
#pragma unroll
            for (int bj = 0; bj < 2; ++bj) { const u16* zp = GS + (ai * 128 + m * 16) * 256 + bj * 128; ga[q][bj] = *(const u32x4*)zp; gb[q][bj] = *(const u32x4*)(zp + 65536); } }
#pragma unroll
        for (int q = 0; q < 2; ++q) { const int am = pr * 2 + q, ai = am >> 2, m = am & 3;
#pragma unroll
            for (int bj = 0; bj < 2; ++bj) { float f[8];
#pragma unroll
                for (int j = 0; j < 4; ++j) { f[2 * j] = bflo(gb[q][bj][j]) * __builtin_amdgcn_rcpf(bflo(ga[q][bj][j]));
                    f[2 * j + 1] = bfhi(gb[q][bj][j]) * __builtin_amdgcn_rcpf(bfhi(ga[q][bj][j])); }
                acc[ai][bj][m][0] *= (f32x4){f[0], f[1], f[2], f[3]}; acc[ai][bj][m][1] *= (f32x4){f[4], f[5], f[6], f[7]}; } }
        asm volatile("" ::: "memory"); }
}
DI void gemm_multi(PG8_LAS unsigned char* lds, const Params& p, const GDesc d0, const GDesc d1, const GDesc d2, const GDesc d3, const MSched& S, size_t rsoff) {
    using namespace pg8;
    const int tid = otid(), wid = __builtin_amdgcn_readfirstlane(tid >> 6), lane = tid & 63, wr = wid >> 2, wc = wid & 3, fr = lane & 15, fq = lane >> 4;
    unsigned ra2[2], rb2[2], c2[2];
#pragma unroll
    for (int i = 0; i < 2; ++i) { int R, C; stage_rc(tid * 16 + i * 8192, R, C); ra2[i] = (unsigned)R * 2u; rb2[i] = (unsigned)((R & ~31) + perm32(R & 31)) * 2u; c2[i] = (unsigned)C * 2u; }
    const size_t kstep = (size_t)(BK * 2);
    const unsigned ldsw = (unsigned)wid * 1024u;
    const int aoff = lds_byte(wr * 64 + fr, fq * 8), boff = lds_byte(wc * 32 + fr, fq * 8);
#define PG8_SA(b, h) (((b) * 2 + (h)) * HTB)
#define PG8_SB(b, h) ((4 + (b) * 2 + (h)) * HTB)
#define PG8_STAGE(bufoff, gbase, voff) do { _Pragma("unroll") for (int _i = 0; _i < 2; ++_i) \
        __builtin_amdgcn_global_load_lds((const unsigned*)((const char*)(gbase) + (voff)[_i]), (PG8_LAS unsigned*)(lds + (bufoff) + ldsw + _i * 8192), 16, 0, 0); } while (0)
#define PG8_LDA(dst, b, h) do { _Pragma("unroll") for (int m = 0; m < 4; ++m) _Pragma("unroll") for (int k = 0; k < 2; ++k) dst[m][k] = *(const PG8_LAS bf16x8*)(lds + PG8_SA(b, h) + aoff + m * 2048 + k * 1024); } while (0)
#define PG8_LDB(dst, b, h) do { _Pragma("unroll") for (int n = 0; n < 2; ++n) _Pragma("unroll") for (int k = 0; k < 2; ++k) dst[n][k] = *(const PG8_LAS bf16x8*)(lds + PG8_SB(b, h) + boff + n * 2048 + k * 1024); } while (0)
#define PG8_MMA(ai, bj, At, Bt) do { __builtin_amdgcn_s_setprio(1); _Pragma("unroll") for (int m = 0; m < 4; ++m) _Pragma("unroll") for (int n = 0; n < 2; ++n) _Pragma("unroll") for (int k = 0; k < 2; ++k) \
        acc[ai][bj][m][n] = __builtin_amdgcn_mfma_f32_16x16x32_bf16(Bt[n][k], At[m][k], acc[ai][bj][m][n], 0, 0, 0); __builtin_amdgcn_s_setprio(0); } while (0)
#define PG8_WAIT_V(n) asm volatile("s_waitcnt vmcnt(" #n ")" ::: "memory")
#define PG8_WAIT_L(n) asm volatile("s_waitcnt lgkmcnt(" #n ")" ::: "memory")
#define PG8_BAR __builtin_amdgcn_s_barrier()
#define PG8_SCHED __builtin_amdgcn_sched_barrier(0)
#define GSEL(gi, f) ((gi) == 0 ? d0.f + 0 : ((gi) == 1 ? d1.f + 0 : ((gi) == 2 ? d2.f + 0 : d3.f + 0)))
    MUnit cur, nxt; int ui = 0;
    if (!S.next(0, cur)) return;
    f32x4 acc[2][2][4][2];
#pragma unroll
    for (int a = 0; a < 2; ++a)
#pragma unroll
        for (int b = 0; b < 2; ++b)
#pragma unroll
            for (int m = 0; m < 4; ++m)
#pragma unroll
                for (int n = 0; n < 2; ++n) acc[a][b][m][n] = (f32x4){0.f, 0.f, 0.f, 0.f};
    bf16x8 At[4][2], B0[2][2], B1[2][2];
    int Kc = GSEL(cur.gi, K); int modec = GSEL(cur.gi, mode);
    const char* cA = (const char*)GSEL(cur.gi, A) + (size_t)cur.pm * ((size_t)512 * Kc); const char* cB = (const char*)GSEL(cur.gi, Bt) + (size_t)cur.pn * ((size_t)512 * Kc);
    {
        const size_t hstep = (size_t)HALF * Kc * 2; unsigned vA[2], vB[2];
#pragma unroll
        for (int i = 0; i < 2; ++i) { vA[i] = ra2[i] * (unsigned)Kc + c2[i]; vB[i] = rb2[i] * (unsigned)Kc + c2[i]; }
        PG8_STAGE(PG8_SB(0, 0), cB, vB); PG8_STAGE(PG8_SA(0, 0), cA, vA); PG8_STAGE(PG8_SB(0, 1), cB + hstep, vB); PG8_STAGE(PG8_SA(0, 1), cA + hstep, vA);
        if (wr == 1) PG8_BAR;
        PG8_WAIT_V(4); PG8_BAR;
        PG8_STAGE(PG8_SB(1, 0), cB + kstep, vB); PG8_STAGE(PG8_SA(1, 0), cA + kstep, vA); PG8_STAGE(PG8_SB(1, 1), cB + hstep + kstep, vB);
        PG8_WAIT_V(6); PG8_BAR;
    }
    for (;;) {
        const bool has_next = S.next(ui + 1, nxt);
        const int Kn = has_next ? GSEL(nxt.gi, K) : Kc; const int moden = has_next ? GSEL(nxt.gi, mode) : modec;
        const char* nA = has_next ? (const char*)GSEL(nxt.gi, A) + (size_t)nxt.pm * ((size_t)512 * Kn) : cA; const char* nB = has_next ? (const char*)GSEL(nxt.gi, Bt) + (size_t)nxt.pn * ((size_t)512 * Kn) : cB;
        const int nt = Kc / BK; const size_t hstepc = (size_t)HALF * Kc * 2;
        unsigned vAc[2];
#pragma unroll
        for (int i = 0; i < 2; ++i) vAc[i] = ra2[i] * (unsigned)Kc + c2[i];
        for (int t = 0; t < nt; t += 2) {
            const bool last = (t == nt - 2);
            const int K2 = last ? Kn : Kc; const size_t hstep2 = (size_t)HALF * K2 * 2;
            unsigned vA2[2], vB2[2];
#pragma unroll
            for (int i = 0; i < 2; ++i) { vA2[i] = ra2[i] * (unsigned)K2 + c2[i]; vB2[i] = rb2[i] * (unsigned)K2 + c2[i]; }
            const char* a1 = cA + (size_t)(t + 1) * kstep;
            const char* a2 = last ? nA : cA + (size_t)(t + 2) * kstep; const char* b2 = last ? nB : cB + (size_t)(t + 2) * kstep;
            const char* a3 = a2 + kstep; const char* b3 = b2 + kstep;
            PG8_LDB(B0, 0, 0); PG8_SCHED; PG8_LDA(At, 0, 0); PG8_STAGE(PG8_SA(1, 1), a1 + hstepc, vAc);
            PG8_WAIT_L(8); PG8_BAR; PG8_WAIT_L(0); PG8_MMA(0, 0, At, B0); PG8_BAR; PG8_SCHED;
            PG8_LDB(B1, 0, 1); PG8_STAGE(PG8_SB(0, 0), b2, vB2);
            PG8_BAR; PG8_WAIT_L(0); PG8_MMA(0, 1, At, B1); PG8_BAR;
            PG8_LDA(At, 0, 1); PG8_STAGE(PG8_SA(0, 0), a2, vA2);
            PG8_BAR; PG8_WAIT_L(0); PG8_MMA(1, 0, At, B0); PG8_BAR; PG8_SCHED;
            PG8_STAGE(PG8_SB(0, 1), b2 + hstep2, vB2);
            PG8_WAIT_V(6); PG8_BAR; PG8_MMA(1, 1, At, B1); PG8_BAR;
            PG8_LDB(B0, 1, 0); PG8_SCHED; PG8_LDA(At, 1, 0); PG8_STAGE(PG8_SA(0, 1), a2 + hstep2, vA2);
            PG8_WAIT_L(8); PG8_BAR; PG8_WAIT_L(0); PG8_MMA(0, 0, At, B0); PG8_BAR; PG8_SCHED;
            PG8_LDB(B1, 1, 1); PG8_STAGE(PG8_SB(1, 0), b3, vB2);
            PG8_BAR; PG8_WAIT_L(0); PG8_MMA(0, 1, At, B1); PG8_BAR;
            PG8_LDA(At, 1, 1); PG8_STAGE(PG8_SA(1, 0), a3, vA2);
            PG8_BAR; PG8_WAIT_L(0); PG8_MMA(1, 0, At, B0); PG8_BAR; PG8_SCHED;
            PG8_STAGE(PG8_SB(1, 1), b3 + hstep2, vB2);
            PG8_WAIT_V(6); PG8_BAR; PG8_MMA(1, 1, At, B1); PG8_BAR;
            if (modec == 6 && (t == 2 || t == 10)) gate_scale(p, acc, cur, t == 2 ? 0 : 1);
        }
        if (modec != 5) epi_all(p, modec, acc, cur, rsoff);
        if (!has_next) break;
#pragma unroll
        for (int a = 0; a < 2; ++a)
#pragma unroll
            for (int b = 0; b < 2; ++b)
#pragma unroll
                for (int m = 0; m < 4; ++m)
#pragma unroll
                    for (int n = 0; n < 2; ++n) acc[a][b][m][n] = (f32x4){0.f, 0.f, 0.f, 0.f};
        cur = nxt; cA = nA; cB = nB; Kc = Kn; modec = moden; ++ui;
    }
    PG8_WAIT_V(0);
    if (wr == 0) PG8_BAR;
    PG8_BAR;
    if (modec == 5) epi_fused(p, lds, acc, cur, rsoff);
#undef GSEL
#undef PG8_SA
#undef PG8_SB
#undef PG8_STAGE
#undef PG8_LDA
#undef PG8_LDB
#undef PG8_MMA
#undef PG8_WAIT_V
#undef PG8_WAIT_L
#undef PG8_BAR
#undef PG8_SCHED
}

DI void wg_publish(unsigned* cnt) {
    asm volatile("s_waitcnt vmcnt(0)" ::: "memory");
    __syncthreads();
    if (threadIdx.x == 0) { __builtin_amdgcn_fence(__ATOMIC_RELEASE, "agent"); asm volatile("s_waitcnt vmcnt(0)" ::: "memory"); __hip_atomic_fetch_add(cnt, 1u, __ATOMIC_RELAXED, __HIP_MEMORY_SCOPE_AGENT); }
}
DI void wg_consume(unsigned* cnt, unsigned need) {
    if (threadIdx.x == 0) { unsigned sp = 0;
        while (__hip_atomic_load(cnt, __ATOMIC_RELAXED, __HIP_MEMORY_SCOPE_AGENT) < need) { __builtin_amdgcn_s_sleep(1); if (++sp > (1u << 20)) break; }
        __builtin_amdgcn_fence(__ATOMIC_ACQUIRE, "agent"); asm volatile("s_waitcnt vmcnt(0)" ::: "memory"); }
    __syncthreads();
}
DI void sk_range(f32x4 (&acc)[2], const u16* ap, const u16* bp0, const u16* bp1, int k0, int k1) {
#pragma unroll 8
    for (int k = k0; k < k1; k += 32) { const bf16x8 a = *(const bf16x8*)(ap + k), b0 = *(const bf16x8*)(bp0 + k), b1 = *(const bf16x8*)(bp1 + k);
        acc[0] = MFMA16(b0, a, acc[0]); acc[1] = MFMA16(b1, a, acc[1]); }
}
DI void skinny_tile(const Params& p, int mode, const u16* A, const u16* Bt, int grow0, int n0, size_t rsoff = 0) {
    const int tid = otid(), w = tid >> 6, lane = tid & 63, l15 = lane & 15, g4 = lane >> 4;
    f32x4 acc[2]; acc[0] = (f32x4){0.f, 0.f, 0.f, 0.f}; acc[1] = acc[0];
    const u16* ap = A + (size_t)(16 * w + l15) * 1024 + 8 * g4;
    const u16* bp0 = Bt + (size_t)(n0 + l15) * 1024 + 8 * g4; const u16* bp1 = bp0 + 16 * 1024;
    const size_t grow = (size_t)grow0 + 16 * w + l15;
    const u16* Z = (const u16*)(p.ws + W_Z);
    if (mode == 2) {
        sk_range(acc, ap, bp0, bp1, 0, 256);
#pragma unroll
        for (int which = 0; which < 2; ++which) {
#pragma unroll
            for (int jb = 0; jb < 2; ++jb) { const u16* zp = Z + grow * 8192 + C_ZG + which * 1024 + n0 + 16 * jb + 4 * g4; const u32x2 ga = *(const u32x2*)zp, gb = *(const u32x2*)(zp + 1024);
                acc[jb][0] *= (1.0f + __expf(-bflo(gb[0]))) * __builtin_amdgcn_rcpf(1.0f + __expf(-bflo(ga[0]))); acc[jb][1] *= (1.0f + __expf(-bfhi(gb[0]))) * __builtin_amdgcn_rcpf(1.0f + __expf(-bfhi(ga[0])));
                acc[jb][2] *= (1.0f + __expf(-bflo(gb[1]))) * __builtin_amdgcn_rcpf(1.0f + __expf(-bflo(ga[1]))); acc[jb][3] *= (1.0f + __expf(-bfhi(gb[1]))) * __builtin_amdgcn_rcpf(1.0f + __expf(-bfhi(ga[1]))); }
            if (which == 0) sk_range(acc, ap, bp0, bp1, 256, 768); else sk_range(acc, ap, bp0, bp1, 768, 1024); }
    } else sk_range(acc, ap, bp0, bp1, 0, 1024);
    float ss = 0.f;
#pragma unroll
    for (int jb = 0; jb < 2; ++jb) { const int n = n0 + 16 * jb + 4 * g4; const f32x4 v = acc[jb];
        if (mode == 0) { u32x2 wv = {pk2(v[0], v[1]), pk2(v[2], v[3])}; *(u32x2*)((u16*)(p.ws + W_Z) + grow * 8192 + n) = wv; }
        else if (mode == 1) { u32x2 wv = {pk2(v[0], v[1]), pk2(v[2], v[3])}; *(u32x2*)((u16*)(p.ws + W_MEMKV) + grow * 512 + n) = wv; *(f32x4*)(p.out + O_MKV + grow * 512 + n) = v; }
        else if (mode == 2) { const u32x2 gz = *(const u32x2*)(Z + grow * 8192 + C_ZG + 2048 + n);
            u32x2 wv = {pk2(v[0] * sigmoidf_(bflo(gz[0])), v[1] * sigmoidf_(bfhi(gz[0]))), pk2(v[2] * sigmoidf_(bflo(gz[1])), v[3] * sigmoidf_(bfhi(gz[1])))};
            *(u32x2*)((u16*)(p.ws + W_MERGED) + grow * 1024 + n) = wv; }
        else { const f32x4 r = *(const f32x4*)(p.x_sample + (grow - NTOK_P) * 1024 + n) + v; acc[jb] = r; ss += r[0] * r[0] + r[1] * r[1] + r[2] * r[2] + r[3] * r[3]; } }
    if (mode == 3) {
        float* rowss = (float*)(p.ws + W_ROWSS + rsoff); unsigned* cnt = (unsigned*)(p.ws + W_CNT) + 64 * 64;
        ss += __shfl_xor(ss, 16); ss += __shfl_xor(ss, 32); if (g4 == 0) atomicAdd(rowss + grow, ss);
        asm volatile("s_waitcnt vmcnt(0)" ::: "memory");
        __syncthreads();
        if (tid == 0) { __hip_atomic_fetch_add(cnt, 1u, __ATOMIC_RELAXED, __HIP_MEMORY_SCOPE_AGENT); unsigned sp = 0;
            while (__hip_atomic_load(cnt, __ATOMIC_RELAXED, __HIP_MEMORY_SCOPE_AGENT) < 32u) { __builtin_amdgcn_s_sleep(1); if (++sp > (1u << 20)) break; } }
        __syncthreads();
        const unsigned tb = __hip_atomic_load((unsigned*)(rowss + grow), __ATOMIC_RELAXED, __HIP_MEMORY_SCOPE_AGENT); const float rs = rsqrtf(__uint_as_float(tb) * (1.0f / 1024.0f) + EPSN);
#pragma unroll
        for (int jb = 0; jb < 2; ++jb) { const int n = n0 + 16 * jb + 4 * g4; *(f32x4*)(p.out + grow * 1024 + n) = acc[jb] * rs * *(const f32x4*)(p.norm_final + n); } }
}
DI void phase_skinny(const Params& p, int ph, size_t rsoff) {
    if (ph == 1) { for (int it = blockIdx.x; it < 256; it += gridDim.x) {
            if (it < 256) skinny_tile(p, 0, (const u16*)(p.ws + W_H) + (size_t)NTOK_P * 1024, (const u16*)(p.ws + W_WINT), NTOK_P, it * 32);
            else { const int q = it - 256, rg = q >> 4, cb = q & 15; skinny_tile(p, 1, (const u16*)(p.ws + W_HM) + (size_t)rg * 128 * 1024, (const u16*)(p.ws + W_WMEMT), rg * 128, cb * 32); } } }
    else if (ph == 5) { for (int it = blockIdx.x; it < 32; it += gridDim.x) skinny_tile(p, 2, (const u16*)(p.ws + W_UA) + (size_t)NTOK_P * 1024, (const u16*)(p.ws + W_WAT), NTOK_P, it * 32); }
    else { for (int it = blockIdx.x; it < 32; it += gridDim.x) skinny_tile(p, 3, (const u16*)(p.ws + W_MERGED) + (size_t)NTOK_P * 1024, (const u16*)(p.ws + W_WOUTT), NTOK_P, it * 32, rsoff); }
}

struct AttnItem { int is_mem, b, h, grp, dil, r, nb; };
struct AttnRegs { uint4 k[4], va[2], vb[2]; bf16x8 q0, q1; };
DI AttnItem attn_decode(int idx  ) {
    AttnItem a; a.grp = 0; a.dil = 1; a.r = 0;
    if (idx >= 1536) { idx -= 1536; a.is_mem = 1; a.b = idx >> 8; a.h = (idx >> 6) & 3; a.nb = idx & 63; }
    else { a.is_mem = 0; a.grp = idx >> 9; const int rem = idx & 511; a.b = rem >> 8; a.h = (rem >> 6) & 3; const int c = rem & 63; a.dil = a.grp == 0 ? 1 : (a.grp == 1 ? 4 : 16);
           const int nbc = 64 / a.dil; a.r = c / nbc; a.nb = c % nbc; }
    return a;
}
DI size_t attn_qrow(const AttnItem& a, int qi) { return a.is_mem ? ((size_t)a.b * 8192 + a.nb * 128 + qi) : ((size_t)a.b * 8192 + (size_t)(a.nb * 128 + qi) * a.dil + a.r); }
DI void attn_load(const Params& p, const AttnItem& a, AttnRegs& R) {
    const u16* Z = (const u16*)(p.ws + W_Z); const u16* MK = (const u16*)(p.ws + W_MEMKV);
    const int tid = otid(), w = tid >> 6, lane = tid & 63, l15 = lane & 15, g4 = lane >> 4;
    const uint4 z4 = {0u, 0u, 0u, 0u};
#pragma unroll
    for (int it = 0; it < 4; ++it) { const int c = tid + 512 * it, kr = c >> 3, seg = c & 7; uint4 v = z4;
        if (a.is_mem) v = *(const uint4*)(MK + (size_t)(a.b * 256 + kr) * 512 + a.h * 64 + seg * 8);
        else { const int uu = (a.nb - 1) * 128 + kr; if (uu >= 0) v = *(const uint4*)(Z + ((size_t)a.b * 8192 + (size_t)uu * a.dil + a.r) * 8192 + C_KA + a.grp * 256 + a.h * 64 + seg * 8); }
        R.k[it] = v; }
#pragma unroll
    for (int it = 0; it < 2; ++it) { const int un = tid + 512 * it, seg = un & 7, kp = un >> 3; uint4 va = z4, vb = z4;
        if (a.is_mem) { const u16* s = MK + (size_t)(a.b * 256 + 2 * kp) * 512 + 256 + a.h * 64 + seg * 8; va = *(const uint4*)s; vb = *(const uint4*)(s + 512); }
        else { const int uu = (a.nb - 1) * 128 + 2 * kp; if (uu >= 0) { const u16* s = Z + ((size_t)a.b * 8192 + (size_t)uu * a.dil + a.r) * 8192 + C_VA + a.grp * 256 + a.h * 64 + seg * 8;
                   va = *(const uint4*)s; vb = *(const uint4*)(s + (size_t)a.dil * 8192); } }
        R.va[it] = va; R.vb[it] = vb; }
    const u16* qp = Z + attn_qrow(a, 16 * w + l15) * 8192 + (a.is_mem ? C_QM : C_QA + a.grp * 256) + a.h * 64 + g4 * 8;
    R.q0 = *(const bf16x8*)qp; R.q1 = *(const bf16x8*)(qp + 32);
}
DI void attn_stage(char* smem, const AttnRegs& R) {
    const int tid = otid();
    u16* Ks = (u16*)smem;
    unsigned* VT = (unsigned*)(smem + 36864);
#pragma unroll
    for (int it = 0; it < 4; ++it) { const int c = tid + 512 * it, kr = c >> 3, seg = c & 7; *(uint4*)(Ks + kr * 72 + seg * 8) = R.k[it]; }
#pragma unroll
    for (int it = 0; it < 2; ++it) { const int un = tid + 512 * it, seg = un & 7, kp = un >> 3; const uint4 va = R.va[it], vb = R.vb[it];
        unsigned* d = VT + (seg * 8) * 129 + kp;
        d[0 * 129] = (va.x & 0xffffu) | (vb.x << 16); d[1 * 129] = (va.x >> 16) | (vb.x & 0xffff0000u);
        d[2 * 129] = (va.y & 0xffffu) | (vb.y << 16); d[3 * 129] = (va.y >> 16) | (vb.y & 0xffff0000u);
        d[4 * 129] = (va.z & 0xffffu) | (vb.z << 16); d[5 * 129] = (va.z >> 16) | (vb.z & 0xffff0000u);
        d[6 * 129] = (va.w & 0xffffu) | (vb.w << 16); d[7 * 129] = (va.w >> 16) | (vb.w & 0xffff0000u); }
}
DI void attn_compute(const Params& p, char* smem, const AttnItem& a, const bf16x8 qf0, const bf16x8 qf1) {
    const u16* Z = (const u16*)(p.ws + W_Z);
    const int tid = otid(), w = tid >> 6, lane = tid & 63, l15 = lane & 15, g4 = lane >> 4;
    const u16* Ks = (const u16*)smem; const unsigned* VT = (const unsigned*)(smem + 36864);
    const bool is_mem = a.is_mem != 0; const int nb = a.nb, h = a.h, grp = a.grp;
    const int qi = 16 * w + l15; const size_t qrow = attn_qrow(a, qi);
    f32x4 s[16];
#pragma unroll
    for (int kg = 0; kg < 4; ++kg) { bf16x8 ka[4][2];
#pragma unroll
        for (int i = 0; i < 4; ++i) { const u16* kp_ = Ks + ((kg * 4 + i) * 16 + l15) * 72 + g4 * 8; ka[i][0] = *(const bf16x8*)kp_; ka[i][1] = *(const bf16x8*)(kp_ + 32); }
        __builtin_amdgcn_sched_barrier(0);
#pragma unroll
        for (int i = 0; i < 4; ++i) { f32x4 acc = {0.f, 0.f, 0.f, 0.f}; acc = MFMA16(ka[i][0], qf0, acc); acc = MFMA16(ka[i][1], qf1, acc); s[kg * 4 + i] = acc; }
        __builtin_amdgcn_sched_barrier(0); }
    const float c1 = 0.125f * 1.4426950408889634f;
    float mx = -1e30f;
#pragma unroll
    for (int kb = 0; kb < 16; ++kb)
#pragma unroll
        for (int j = 0; j < 4; ++j) { const float v = s[kb][j] * c1; s[kb][j] = v; mx = fmaxf(mx, v); }
    mx = fmaxf(mx, __shfl_xor(mx, 16)); mx = fmaxf(mx, __shfl_xor(mx, 32));
    float l = 0.f;
#pragma unroll
    for (int kb = 0; kb < 16; ++kb)
#pragma unroll
        for (int j = 0; j < 4; ++j) { const float e = __builtin_amdgcn_exp2f(s[kb][j] - mx); s[kb][j] = e; l += e; }
    l += __shfl_xor(l, 16); l += __shfl_xor(l, 32);
    f32x4 o[4];
#pragma unroll
    for (int db = 0; db < 4; ++db) o[db] = (f32x4){0.f, 0.f, 0.f, 0.f};
#pragma unroll
    for (int k2 = 0; k2 < 4; ++k2) { unsigned vr[2][4][4];
#pragma unroll
        for (int q = 0; q < 2; ++q)
#pragma unroll
            for (int db = 0; db < 4; ++db) { const unsigned* vp = VT + (db * 16 + l15) * 129 + 16 * (2 * k2 + q) + 2 * g4; vr[q][db][0] = vp[0]; vr[q][db][1] = vp[1]; vr[q][db][2] = vp[8]; vr[q][db][3] = vp[9]; }
        const bf16x8 pf0 = pack8(s[4 * k2], s[4 * k2 + 1]), pf1 = pack8(s[4 * k2 + 2], s[4 * k2 + 3]);
        __builtin_amdgcn_sched_barrier(0);
#pragma unroll
        for (int db = 0; db < 4; ++db) o[db] = MFMA16(mk8(vr[0][db][0], vr[0][db][1], vr[0][db][2], vr[0][db][3]), pf0, o[db]);
#pragma unroll
        for (int db = 0; db < 4; ++db) o[db] = MFMA16(mk8(vr[1][db][0], vr[1][db][1], vr[1][db][2], vr[1][db][3]), pf1, o[db]);
        __builtin_amdgcn_sched_barrier(0); }
    const float inv = 1.0f / l;
    if (is_mem) { u16* UM = (u16*)(p.ws + W_UA) + 768;
#pragma unroll
        for (int db = 0; db < 4; ++db) { const int c = h * 64 + db * 16 + 4 * g4; const u32x2 gw = *(const u32x2*)(Z + qrow * 8192 + C_GM + c);
            u32x2 wv = {pk2(o[db][0] * inv * siluf_(bflo(gw[0])), o[db][1] * inv * siluf_(bfhi(gw[0]))), pk2(o[db][2] * inv * siluf_(bflo(gw[1])), o[db][3] * inv * siluf_(bfhi(gw[1])))};
            *(u32x2*)(UM + qrow * 1024 + c) = wv; } }
    else { u16* OA = (u16*)(p.ws + W_OA); float* LSE = (float*)(p.ws + W_LSE); const size_t ro = (size_t)grp * NTOK + qrow;
#pragma unroll
        for (int db = 0; db < 4; ++db) { u32x2 wv = {pk2(o[db][0] * inv, o[db][1] * inv), pk2(o[db][2] * inv, o[db][3] * inv)};
            *(u32x2*)(OA + ro * 256 + h * 64 + db * 16 + 4 * g4) = wv; }
        if (g4 == 0) LSE[ro * 4 + h] = mx * 0.6931471805599453f + __logf(l); }
}

DI void hg_local(const Params& p, char* smem, int item) {
    const u16* Z = (const u16*)(p.ws + W_Z);
    const int tid = otid(), w = tid >> 6, lane = tid & 63, l15 = lane & 15, g4 = lane >> 4;
    const int bh = item >> 5, sc = item & 31, b = bh >> 2, h = bh & 3;
    const size_t row0 = (size_t)b * 8192 + sc * 256;
    u16* KT = (u16*)smem;
    u16* VT = (u16*)(smem + 34816);
    float* segprod = (float*)(smem + 69632);
    float* carry = segprod + 512;
    const int dk = tid & 127, seg = tid >> 7;
    const float lb = 1.0f / (1.0f + __expf(p.lb_logits[512 + h * 128 + dk] - p.lb_logits[h * 128 + dk]));
    if (tid < 128) carry[tid] = 1.0f;
    f32x4 S[8];
#pragma unroll
    for (int i = 0; i < 8; ++i) S[i] = (f32x4){0.f, 0.f, 0.f, 0.f};
    for (int c = 1; c >= 0; --c) {
        const size_t rbase = row0 + c * 128 + seg * 32;
        float f[32]; float prod = 1.0f;
#pragma unroll
        for (int i = 0; i < 32; ++i) { const float fb = bf2f(Z[(rbase + i) * 8192 + C_FB + h * 128 + dk]); f[i] = lb + (1.0f - lb) * sigmoidf_(fb); prod *= f[i]; }
        segprod[seg * 128 + dk] = prod;
#pragma unroll
        for (int i8 = 0; i8 < 4; ++i8) { unsigned wv[4];
#pragma unroll
            for (int j = 0; j < 4; ++j) { const unsigned lo = Z[(rbase + i8 * 8 + 2 * j) * 8192 + C_IB + h * 128 + dk], hi = Z[(rbase + i8 * 8 + 2 * j + 1) * 8192 + C_IB + h * 128 + dk]; wv[j] = lo | (hi << 16); }
            *(u32x4*)(VT + dk * 136 + seg * 32 + i8 * 8) = (u32x4){wv[0], wv[1], wv[2], wv[3]}; }
        __syncthreads();
        float run = carry[dk];
        for (int s2 = seg + 1; s2 < 4; ++s2) run *= segprod[s2 * 128 + dk];
#pragma unroll
        for (int i8 = 3; i8 >= 0; --i8) { float kt[8];
#pragma unroll
            for (int j = 7; j >= 0; --j) { const int i = i8 * 8 + j; kt[j] = (1.0f - f[i]) * run; run *= f[i]; }
            *(u32x4*)(KT + dk * 136 + seg * 32 + i8 * 8) = (u32x4){pk2(kt[0], kt[1]), pk2(kt[2], kt[3]), pk2(kt[4], kt[5]), pk2(kt[6], kt[7])}; }
        __syncthreads();
#pragma unroll
        for (int ks = 0; ks < 4; ++ks) { const bf16x8 bv = *(const bf16x8*)(VT + (16 * w + l15) * 136 + ks * 32 + g4 * 8); bf16x8 av[8];
#pragma unroll
            for (int blk = 0; blk < 8; ++blk) av[blk] = *(const bf16x8*)(KT + (16 * blk + l15) * 136 + ks * 32 + g4 * 8);
            __builtin_amdgcn_sched_barrier(0);
#pragma unroll
            for (int blk = 0; blk < 8; ++blk) S[blk] = MFMA16(av[blk], bv, S[blk]);
            __builtin_amdgcn_sched_barrier(0); }
        __syncthreads();
        if (tid < 128) carry[tid] = carry[tid] * segprod[tid] * segprod[128 + tid] * segprod[256 + tid] * segprod[384 + tid];
        __syncthreads();
    }
    float* ASC = (float*)(p.ws + W_ASC); float* SLOC = (float*)(p.ws + W_SLOC) + (size_t)item * 16384;
    if (tid < 128) ASC[item * 128 + tid] = carry[tid];
#pragma unroll
    for (int blk = 0; blk < 8; ++blk)
#pragma unroll
        for (int j = 0; j < 4; ++j) SLOC[(16 * blk + 4 * g4 + j) * 128 + 16 * w + l15] = S[blk][j];
    asm volatile("s_waitcnt vmcnt(0)" ::: "memory");
    __syncthreads();
    if (tid == 0) { __builtin_amdgcn_fence(__ATOMIC_RELEASE, "agent"); asm volatile("s_waitcnt vmcnt(0)" ::: "memory");
        __hip_atomic_fetch_add((unsigned*)(p.ws + W_BAR), 1u, __ATOMIC_RELAXED, __HIP_MEMORY_SCOPE_AGENT); }
}

DI void hg_out(const Params& p, char* smem, int item) {
    const u16* Z = (const u16*)(p.ws + W_Z);
    const int tid = otid(), w = tid >> 6, lane = tid & 63, l15 = lane & 15, g4 = lane >> 4;
    const int bh = item >> 5, sc = item & 31, b = bh >> 2, h = bh & 3;
    const size_t row0 = (size_t)b * 8192 + sc * 256;
    u16* QT = (u16*)smem;
    u16* KH = (u16*)(smem + 8704);
    u16* KT = (u16*)(smem + 17408);
    u16* VT = (u16*)(smem + 27648);
    float* plast = (float*)(smem + 37888);
    float* tqp = plast + 128;
    float* part = tqp + 512;
    const int dk = tid & 127, tq = tid >> 7;
    const float lb = 1.0f / (1.0f + __expf(p.lb_logits[512 + h * 128 + dk] - p.lb_logits[h * 128 + dk]));
    f32x4 S[8];
    { const float* ss = (const float*)(p.ws + W_SSTART) + (size_t)item * 16384;
#pragma unroll
      for (int blk = 0; blk < 8; ++blk)
#pragma unroll
          for (int j = 0; j < 4; ++j) S[blk][j] = ss[(16 * blk + 4 * g4 + j) * 128 + 16 * w + l15]; }
    const f32x4 gain = *(const f32x4*)(p.norm_hgrn + h * 128 + 16 * w + 4 * g4);
    u16* UB = (u16*)(p.ws + W_UA) + 256;
    u16 rf[8], rq[8], rv[8];
#pragma unroll
    for (int j = 0; j < 8; ++j) { const u16* zr = Z + (row0 + tq * 8 + j) * 8192 + h * 128 + dk; rf[j] = zr[C_FB]; rq[j] = zr[C_QB]; rv[j] = zr[C_IB]; }
    for (int ch = 0; ch < 8; ++ch) {
        float f[8], P[8], qv[8]; float prod = 1.0f;
#pragma unroll
        for (int j = 0; j < 8; ++j) { f[j] = lb + (1.0f - lb) * sigmoidf_(bf2f(rf[j])); prod *= f[j]; P[j] = prod; qv[j] = siluf_(bf2f(rq[j])); }
        tqp[tq * 128 + dk] = prod;
        *(u32x4*)(VT + dk * 40 + tq * 8) = (u32x4){(unsigned)rv[0] | ((unsigned)rv[1] << 16), (unsigned)rv[2] | ((unsigned)rv[3] << 16), (unsigned)rv[4] | ((unsigned)rv[5] << 16), (unsigned)rv[6] | ((unsigned)rv[7] << 16)};
        if (ch < 7) {
#pragma unroll
            for (int j = 0; j < 8; ++j) { const u16* zr = Z + (row0 + (ch + 1) * 32 + tq * 8 + j) * 8192 + h * 128 + dk; rf[j] = zr[C_FB]; rq[j] = zr[C_QB]; rv[j] = zr[C_IB]; } }
        __syncthreads();
        float pbase = 1.0f;
        for (int t2 = 0; t2 < tq; ++t2) pbase *= tqp[t2 * 128 + dk];
        const float ptot = tqp[dk] * tqp[128 + dk] * tqp[256 + dk] * tqp[384 + dk];
        float kt[8];
#pragma unroll
        for (int j = 0; j < 8; ++j) { const float Pj = pbase * P[j], ipj = __builtin_amdgcn_rcpf(Pj), kk = 1.0f - f[j];
            QT[(tq * 8 + j) * 136 + dk] = f2bf(qv[j] * Pj); KH[(tq * 8 + j) * 136 + dk] = f2bf(kk * ipj); kt[j] = kk * ptot * ipj; }
        *(u32x4*)(KT + dk * 40 + tq * 8) = (u32x4){pk2(kt[0], kt[1]), pk2(kt[2], kt[3]), pk2(kt[4], kt[5]), pk2(kt[6], kt[7])};
        if (tq == 0) plast[dk] = ptot;
        __syncthreads();
        f32x4 a00 = {0.f, 0.f, 0.f, 0.f}, a01 = a00, a11 = a00;
#pragma unroll
        for (int ks = 0; ks < 4; ++ks) { const int off = ks * 32 + g4 * 8;
            const bf16x8 k0 = *(const bf16x8*)(KH + l15 * 136 + off), k1 = *(const bf16x8*)(KH + (16 + l15) * 136 + off);
            const bf16x8 q0 = *(const bf16x8*)(QT + l15 * 136 + off), q1 = *(const bf16x8*)(QT + (16 + l15) * 136 + off);
            a00 = MFMA16(k0, q0, a00); a01 = MFMA16(k0, q1, a01); a11 = MFMA16(k1, q1, a11); }
#pragma unroll
        for (int j = 0; j < 4; ++j) { const bool ok = (4 * g4 + j) <= l15; a00[j] = ok ? a00[j] : 0.f; a11[j] = ok ? a11[j] : 0.f; }
        f32x4 o0 = {0.f, 0.f, 0.f, 0.f}, o1 = o0;
#pragma unroll
        for (int ks = 0; ks < 4; ++ks) { const bf16x8 sb = pack8(S[2 * ks], S[2 * ks + 1]);
            const u16* q0p = QT + l15 * 136 + ks * 32 + 4 * g4; const u16* q1p = q0p + 16 * 136;
            const u32x2 a = *(const u32x2*)q0p, bq = *(const u32x2*)(q0p + 16), c = *(const u32x2*)q1p, d = *(const u32x2*)(q1p + 16);
            o0 = MFMA16(sb, mk8(a[0], a[1], bq[0], bq[1]), o0); o1 = MFMA16(sb, mk8(c[0], c[1], d[0], d[1]), o1); }
        { const u16* vp = VT + (16 * w + l15) * 40 + 4 * g4; const u32x2 vlo = *(const u32x2*)vp, vhi = *(const u32x2*)(vp + 16);
          const bf16x8 va = mk8(vlo[0], vlo[1], vhi[0], vhi[1]); const f32x4 zz = {0.f, 0.f, 0.f, 0.f};
          o0 = MFMA16(va, pack8(a00, zz), o0); o1 = MFMA16(va, pack8(a01, a11), o1); }
        { const bf16x8 vb = *(const bf16x8*)(VT + (16 * w + l15) * 40 + g4 * 8);
#pragma unroll
          for (int blk = 0; blk < 8; ++blk) { const f32x4 pl = *(const f32x4*)(plast + 16 * blk + 4 * g4);
              S[blk] = MFMA16(*(const bf16x8*)(KT + (16 * blk + l15) * 40 + g4 * 8), vb, S[blk] * pl); } }
        { float q0 = o0[0] * o0[0] + o0[1] * o0[1] + o0[2] * o0[2] + o0[3] * o0[3], q1 = o1[0] * o1[0] + o1[1] * o1[1] + o1[2] * o1[2] + o1[3] * o1[3];
          q0 += __shfl_xor(q0, 16); q0 += __shfl_xor(q0, 32); q1 += __shfl_xor(q1, 16); q1 += __shfl_xor(q1, 32);
          if (g4 == 0) { part[w * 32 + l15] = q0; part[w * 32 + 16 + l15] = q1; } }
        __syncthreads();
#pragma unroll
        for (int tb = 0; tb < 2; ++tb) { const int t = 16 * tb + l15; float tot = 0.f;
#pragma unroll
            for (int ww = 0; ww < 8; ++ww) tot += part[ww * 32 + t];
            const float rs = rsqrtf(tot * (1.0f / 128.0f) + EPSN); const size_t row = row0 + ch * 32 + t; const f32x4 o = tb ? o1 : o0;
            const u32x2 gw = *(const u32x2*)(Z + row * 8192 + C_GB + h * 128 + 16 * w + 4 * g4);
            u32x2 wv = {pk2(o[0] * rs * gain[0] * siluf_(bflo(gw[0])), o[1] * rs * gain[1] * siluf_(bfhi(gw[0]))),
                        pk2(o[2] * rs * gain[2] * siluf_(bflo(gw[1])), o[3] * rs * gain[3] * siluf_(bfhi(gw[1])))};
            *(u32x2*)(UB + row * 1024 + h * 128 + 16 * w + 4 * g4) = wv; }
    }
    __syncthreads();
}

DI void dec_attn(const Params& p, char* smem, int item) {
    const u16* Z = (const u16*)(p.ws + W_Z);
    int b, src, h, part, np;
    const int tid = otid(), w = tid >> 6, lane = tid & 63, r = lane >> 4, c = lane & 15;
    if (item < 384) { b = item / 3; src = item - 3 * b; h = w & 3; part = w >> 2; np = 2; }
    else { const int q = item - 384; b = q >> 1; src = 3; h = 2 * (q & 1) + (w & 1); part = w >> 1; np = 4; }
    float* po = (float*)smem;
    float* ml = po + 512;
    const int dil = src == 0 ? 1 : (src == 1 ? 4 : 16), L = src == 0 ? 128 : (src == 1 ? 512 : 2048);
    const float* cw1 = p.c_w1; const float* cw2 = p.c_w2; const float* cw3 = p.c_w3; const float* cwm = p.c_mem;
    const float* cache = src == 0 ? cw1 + 0 : (src == 1 ? cw2 + 0 : (src == 2 ? cw3 + 0 : cwm + 0));
    const size_t brow = (size_t)b * (src == 3 ? 256 : L);
    const u16* zrow = Z + (size_t)(NTOK_P + b) * 8192;
    const int qcol = (src == 3 ? C_QM : C_QA + src * 256) + h * 64;
    const u32x2 qw = *(const u32x2*)(zrow + qcol + c * 4);
    const float q0 = bflo(qw[0]) * 0.125f, q1 = bfhi(qw[0]) * 0.125f, q2 = bflo(qw[1]) * 0.125f, q3 = bfhi(qw[1]) * 0.125f;
    const int j0 = part * 64;
    float m_run, l_run; float4 o = {0.f, 0.f, 0.f, 0.f};
    {
        float4 K[16], V[16];
#pragma unroll
        for (int it = 0; it < 16; ++it) { const int j = j0 + it * 4 + r; const int row = src == 3 ? j : L - dil * (j + 1);
            const float* kp = cache + (brow + row) * 512 + h * 64 + c * 4; K[it] = *(const float4*)kp; V[it] = *(const float4*)(kp + 256); }
        float s[16]; float mc = -1e30f;
#pragma unroll
        for (int it = 0; it < 16; ++it) { float d = K[it].x * q0 + K[it].y * q1 + K[it].z * q2 + K[it].w * q3;
            d += __shfl_xor(d, 1); d += __shfl_xor(d, 2); d += __shfl_xor(d, 4); d += __shfl_xor(d, 8); s[it] = d; mc = fmaxf(mc, d); }
        mc = fmaxf(mc, __shfl_xor(mc, 16)); mc = fmaxf(mc, __shfl_xor(mc, 32));
        m_run = mc; l_run = 0.f;
#pragma unroll
        for (int it = 0; it < 16; ++it) { const float pe = __expf(s[it] - mc); l_run += pe; o.x += pe * V[it].x; o.y += pe * V[it].y; o.z += pe * V[it].z; o.w += pe * V[it].w; }
    }
    l_run += __shfl_xor(l_run, 16); l_run += __shfl_xor(l_run, 32);
    o.x += __shfl_xor(o.x, 16); o.x += __shfl_xor(o.x, 32); o.y += __shfl_xor(o.y, 16); o.y += __shfl_xor(o.y, 32);
    o.z += __shfl_xor(o.z, 16); o.z += __shfl_xor(o.z, 32); o.w += __shfl_xor(o.w, 16); o.w += __shfl_xor(o.w, 32);
    if (r == 0) *(float4*)(po + w * 64 + c * 4) = o;
    if (lane == 0) { ml[w * 2] = m_run; ml[w * 2 + 1] = l_run; }
    __syncthreads();
    if (part == 0 && r == 0) {
        const int pstride = src == 3 ? 2 : 4;
        float sn = -1e30f; float4 vn = {0.f, 0.f, 0.f, 0.f};
        if (src < 3) { const u32x2 kw = *(const u32x2*)(zrow + C_KA + src * 256 + h * 64 + c * 4);
            float d = bflo(kw[0]) * q0 + bfhi(kw[0]) * q1 + bflo(kw[1]) * q2 + bfhi(kw[1]) * q3;
            d += __shfl_xor(d, 1); d += __shfl_xor(d, 2); d += __shfl_xor(d, 4); d += __shfl_xor(d, 8); sn = d;
            const u32x2 vw = *(const u32x2*)(zrow + C_VA + src * 256 + h * 64 + c * 4); vn = (float4){bflo(vw[0]), bfhi(vw[0]), bflo(vw[1]), bfhi(vw[1])}; }
        float M = sn;
        for (int k = 0; k < np; ++k) M = fmaxf(M, ml[(w + pstride * k) * 2]);
        const float wn = src < 3 ? __expf(sn - M) : 0.f;
        float l = wn; float4 ov = {wn * vn.x, wn * vn.y, wn * vn.z, wn * vn.w};
        for (int k = 0; k < np; ++k) { const int ww = w + pstride * k; const float wk = __expf(ml[ww * 2] - M); const float4 ok = *(const float4*)(po + ww * 64 + c * 4);
            l += wk * ml[ww * 2 + 1]; ov.x += wk * ok.x; ov.y += wk * ok.y; ov.z += wk * ok.z; ov.w += wk * ok.w; }
        const float inv = 1.0f / l; ov.x *= inv; ov.y *= inv; ov.z *= inv; ov.w *= inv; const size_t tok = NTOK_P + b;
        if (src < 3) { u32x2 wv = {pk2(ov.x, ov.y), pk2(ov.z, ov.w)}; *(u32x2*)((u16*)(p.ws + W_OA) + ((size_t)src * NTOK + tok) * 256 + h * 64 + c * 4) = wv;
            if (c == 0) ((float*)(p.ws + W_LSE))[((size_t)src * NTOK + tok) * 4 + h] = M + __logf(l); }
        else { const u32x2 gw = *(const u32x2*)(zrow + C_GM + h * 64 + c * 4);
            u32x2 wv = {pk2(ov.x * siluf_(bflo(gw[0])), ov.y * siluf_(bfhi(gw[0]))), pk2(ov.z * siluf_(bflo(gw[1])), ov.w * siluf_(bfhi(gw[1])))};
            *(u32x2*)((u16*)(p.ws + W_UA) + tok * 1024 + 768 + h * 64 + c * 4) = wv; } }
    __syncthreads();
}

DI void hg_step(const Params& p, char* smem, int item) {
    const u16* Z = (const u16*)(p.ws + W_Z);
    const int b = item >> 2, h = item & 3, tid = otid();
    const u16* zrow = Z + (size_t)(NTOK_P + b) * 8192;
    float* sf = (float*)smem; float* sq = sf + 128; float* sv = sq + 128; float* red = sv + 128;
    float* sss = red + 2048;
    if (tid < 128) { const int c = h * 128 + tid; const float lb = 1.0f / (1.0f + __expf(p.lb_logits[512 + c] - p.lb_logits[c]));
        sf[tid] = lb + (1.0f - lb) * sigmoidf_(bf2f(zrow[C_FB + c])); sq[tid] = siluf_(bf2f(zrow[C_QB + c])); }
    else if (tid < 256) sv[tid - 128] = bf2f(zrow[C_IB + h * 128 + tid - 128]);
    __syncthreads();
    const int c4 = (tid & 31) * 4, r0 = tid >> 5;
    const float* S0 = p.st_hgrn + (size_t)item * 16384; float* SO = p.out + O_HGS + (size_t)item * 16384;
    const float4 v4 = *(const float4*)(sv + c4);
    float4 oa = {0.f, 0.f, 0.f, 0.f};
#pragma unroll
    for (int i = 0; i < 8; ++i) { const int dkk = r0 + 16 * i; const float f = sf[dkk], k = 1.0f - f, q = sq[dkk];
        float4 s = *(const float4*)(S0 + dkk * 128 + c4);
        s.x = f * s.x + k * v4.x; s.y = f * s.y + k * v4.y; s.z = f * s.z + k * v4.z; s.w = f * s.w + k * v4.w;
        *(float4*)(SO + dkk * 128 + c4) = s;
        oa.x += s.x * q; oa.y += s.y * q; oa.z += s.z * q; oa.w += s.w * q; }
    *(float4*)(red + r0 * 128 + c4) = oa;
    __syncthreads();
    float o = 0.f;
    if (tid < 128) {
#pragma unroll
        for (int r = 0; r < 16; ++r) o += red[r * 128 + tid];
        const float q = wave_sum(o * o); if ((tid & 63) == 0) sss[tid >> 6] = q; }
    __syncthreads();
    if (tid < 128) { const float rs = rsqrtf((sss[0] + sss[1]) * (1.0f / 128.0f) + EPSN); const int c = h * 128 + tid;
        ((u16*)(p.ws + W_UA))[(size_t)(NTOK_P + b) * 1024 + 256 + c] = f2bf(o * rs * p.norm_hgrn[c] * siluf_(bf2f(zrow[C_GB + c]))); }
    __syncthreads();
}

DI void copy_rows_all(const Params& p) {
    const u16* Z = (const u16*)(p.ws + W_Z);
    const int tid = otid();
#pragma unroll
    for (int i = 0; i < 6; ++i) { size_t q = ((size_t)i * gridDim.x + blockIdx.x) * 512 + tid;
        const bool ok = q < 737280; if (!ok) q = 0;
        size_t oo; int g, L = 128; bool samp = false;
        if (q < 32768) { g = 0; L = 128; oo = O_W1P; } else if (q < 163840) { q -= 32768; g = 1; L = 512; oo = O_W2P; } else if (q < 688128) { q -= 163840; g = 2; L = 2048; oo = O_W3P; }
        else { q -= 688128; g = (int)(q >> 14); q &= 16383; samp = true; oo = g == 0 ? O_W1S : (g == 1 ? O_W2S : O_W3S); }
        const size_t e = q * 4; const int hd = (int)(e & 255), kv = (int)((e >> 8) & 1); size_t zr;
        if (samp) zr = NTOK_P + (e >> 9); else { const size_t bj = e >> 9; const int lg = g == 0 ? 7 : (g == 1 ? 9 : 11); const int bb = (int)(bj >> lg), j = (int)(bj & (size_t)(L - 1)); zr = (size_t)bb * 8192 + (8192 - L + j); }
        const u32x2 wv = *(const u32x2*)(Z + zr * 8192 + (kv ? C_VA : C_KA) + g * 256 + hd);
        if (ok) *(f32x4*)(p.out + oo + e) = (f32x4){bflo(wv[0]), bfhi(wv[0]), bflo(wv[1]), bfhi(wv[1])}; }
}

DI void phase_prefix(const Params& p) {
    copy_rows_all(p);
    const float* SLOC = (const float*)(p.ws + W_SLOC); const float* ASC = (const float*)(p.ws + W_ASC); float* SST = (float*)(p.ws + W_SSTART);
    const int tid = otid();
    for (int e = blockIdx.x * 512 + tid; e < 131072; e += gridDim.x * 512) { const int bh = e >> 14, idx = e & 16383, dk = idx >> 7; float s = 0.f;
        for (int s8 = 0; s8 < 4; ++s8) { float a[8], l[8];
#pragma unroll
            for (int j = 0; j < 8; ++j) { const int it = bh * 32 + s8 * 8 + j; a[j] = ASC[it * 128 + dk]; l[j] = SLOC[(size_t)it * 16384 + idx]; }
#pragma unroll
            for (int j = 0; j < 8; ++j) { const int it = bh * 32 + s8 * 8 + j; SST[(size_t)it * 16384 + idx] = s; s = a[j] * s + l[j]; } }
        p.out[O_HGP + e] = s; }
}
DI void attn_compute_win(const Params& p, char* smem, const AttnItem& a, const bf16x8 qf0, const bf16x8 qf1) {
    const int tid = otid(), w = tid >> 6, lane = tid & 63, l15 = lane & 15, g4 = lane >> 4;
    const u16* Ks = (const u16*)smem; const unsigned* VT = (const unsigned*)(smem + 36864);
    const int nb = a.nb, h = a.h, grp = a.grp;
    const int qi = 16 * w + l15; const size_t qrow = attn_qrow(a, qi);
    const u16* kbase = Ks + (w * 16 + l15) * 72 + g4 * 8;
    f32x4 s[9];
#pragma unroll
    for (int kg = 0; kg < 3; ++kg) { bf16x8 ka[4][2];
#pragma unroll
        for (int i = 0; i < 4; ++i) if (kg * 4 + i < 9) { const u16* kp_ = kbase + (kg * 4 + i) * 16 * 72; ka[i][0] = *(const bf16x8*)kp_; ka[i][1] = *(const bf16x8*)(kp_ + 32); }
        __builtin_amdgcn_sched_barrier(0);
#pragma unroll
        for (int i = 0; i < 4; ++i) if (kg * 4 + i < 9) { f32x4 acc = {0.f, 0.f, 0.f, 0.f}; acc = MFMA16(ka[i][0], qf0, acc); acc = MFMA16(ka[i][1], qf1, acc); s[kg * 4 + i] = acc; }
        __builtin_amdgcn_sched_barrier(0); }
    const float c1 = 0.125f * 1.4426950408889634f;
    float mx = -1e30f;
#pragma unroll
    for (int i = 0; i < 9; ++i) { const float bound = (i == 8 || (w + i) >= 8 || nb > 0) ? 3.0e38f : -1e30f;
#pragma unroll
        for (int j = 0; j < 4; ++j) { float v = fminf(s[i][j] * c1, bound);
            if (i == 0) v = (4 * g4 + j >= l15) ? v : -1e30f;
            if (i == 8) v = (4 * g4 + j <= l15) ? v : -1e30f;
            s[i][j] = v; mx = fmaxf(mx, v); } }
    mx = fmaxf(mx, __shfl_xor(mx, 16)); mx = fmaxf(mx, __shfl_xor(mx, 32));
    float l = 0.f;
#pragma unroll
    for (int i = 0; i < 9; ++i)
#pragma unroll
        for (int j = 0; j < 4; ++j) { const float e = __builtin_amdgcn_exp2f(s[i][j] - mx); s[i][j] = e; l += e; }
    l += __shfl_xor(l, 16); l += __shfl_xor(l, 32);
    f32x4 o[4];
#pragma unroll
    for (int db = 0; db < 4; ++db) o[db] = (f32x4){0.f, 0.f, 0.f, 0.f};
    const f32x4 zz = {0.f, 0.f, 0.f, 0.f};
#pragma unroll
    for (int j2 = 0; j2 < 5; ++j2) { unsigned vr[4][4];
#pragma unroll
        for (int db = 0; db < 4; ++db) { const unsigned* vp = VT + (db * 16 + l15) * 129 + 8 * (w + 2 * j2) + 2 * g4; vr[db][0] = vp[0]; vr[db][1] = vp[1];
            if (j2 < 4) { vr[db][2] = vp[8]; vr[db][3] = vp[9]; } else { vr[db][2] = vr[db][0]; vr[db][3] = vr[db][1]; } }
        const bf16x8 pf = j2 < 4 ? pack8(s[2 * j2], s[2 * j2 + 1]) : pack8(s[8], zz);
        __builtin_amdgcn_sched_barrier(0);
#pragma unroll
        for (int db = 0; db < 4; ++db) o[db] = MFMA16(mk8(vr[db][0], vr[db][1], vr[db][2], vr[db][3]), pf, o[db]);
        __builtin_amdgcn_sched_barrier(0); }
    const float inv = 1.0f / l;
    u16* OA = (u16*)(p.ws + W_OA); float* LSE = (float*)(p.ws + W_LSE); const size_t ro = (size_t)grp * NTOK + qrow;
#pragma unroll
    for (int db = 0; db < 4; ++db) { u32x2 wv = {pk2(o[db][0] * inv, o[db][1] * inv), pk2(o[db][2] * inv, o[db][3] * inv)};
        *(u32x2*)(OA + ro * 256 + h * 64 + db * 16 + 4 * g4) = wv; }
    if (g4 == 0) LSE[ro * 4 + h] = mx * 0.6931471805599453f + __logf(l);
}
constexpr int P2_HGL = 256, P2_AT = P2_HGL + 2048, P2_DA = P2_AT + 640, P2_HS = P2_DA + 512, P2_CP = P2_HS;
DI void phase_mix(const Params& p, char* smem, int sub) {
    const int G = (int)gridDim.x;
    if (sub == 31) { unsigned* cm = (unsigned*)(p.ws + W_CNT) + 64 * 65; const int q0 = (int)blockIdx.x - (G >= 192 ? 128 : 0);
        for (int q = q0; q >= 0 && q < 64; q += G) { const int rg = q >> 4, cb = q & 15;
            skinny_tile(p, 1, (const u16*)(p.ws + W_HM) + (size_t)rg * 128 * 1024, (const u16*)(p.ws + W_WMEMT), rg * 128, cb * 32); wg_publish(cm); } }
    int it = blockIdx.x;
    for (; it < P2_HGL; it += G) if (sub & 1) hg_local(p, smem, it);
    if (sub == 31) wg_consume((unsigned*)(p.ws + W_CNT) + 64 * 65, 64u);
    if (!(sub & 2)) { while (it < P2_AT) it += G; }
    if (it < P2_AT) {
        AttnRegs R; AttnItem a = attn_decode(it - P2_HGL); attn_load(p, a, R);
        for (;;) {
            attn_stage(smem, R); const bf16x8 q0 = R.q0, q1 = R.q1;
            __syncthreads();
            const int nx = it + G; const bool more = nx < P2_AT; AttnItem an = a;
            if (more) { an = attn_decode(nx - P2_HGL); attn_load(p, an, R); }
            if (a.is_mem) attn_compute(p, smem, a, q0, q1); else attn_compute_win(p, smem, a, q0, q1);
            __syncthreads();
            it = nx; a = an;
            if (!more) break;
        }
    }
    for (; it < P2_CP; it += G) {
        if (it < P2_DA) { if (sub & 4) dec_attn(p, smem, it - P2_AT); }
        else if (it < P2_HS) { if (sub & 8) hg_step(p, smem, it - P2_DA); }
    }
    if (sub == 31) {
        if (threadIdx.x == 0) { unsigned* cnt = (unsigned*)(p.ws + W_BAR); unsigned sp = 0;
            while (__hip_atomic_load(cnt, __ATOMIC_RELAXED, __HIP_MEMORY_SCOPE_AGENT) < (unsigned)P2_HGL) { __builtin_amdgcn_s_sleep(2); if (++sp > (1u << 20)) break; }
            __builtin_amdgcn_fence(__ATOMIC_ACQUIRE, "agent"); asm volatile("s_waitcnt vmcnt(0)" ::: "memory"); }
        __syncthreads();
        phase_prefix(p);
    }
}

DI void phase_hgout(const Params& p, char* smem) {
    for (int it = blockIdx.x; it < 256; it += gridDim.x) hg_out(p, smem, it);
    const u16* Z = (const u16*)(p.ws + W_Z); const u16* OA = (const u16*)(p.ws + W_OA); const float* LSE = (const float*)(p.ws + W_LSE); u16* UA = (u16*)(p.ws + W_UA);
    const int tid = otid();
    for (size_t q = (size_t)blockIdx.x * 512 + tid; q < (size_t)NTOK * 32; q += (size_t)gridDim.x * 512) { const size_t tok = q >> 5; const int c8 = (int)(q & 31) * 8, h = c8 >> 6;
        const float l0 = LSE[(0 * (size_t)NTOK + tok) * 4 + h], l1 = LSE[(1 * (size_t)NTOK + tok) * 4 + h], l2 = LSE[(2 * (size_t)NTOK + tok) * 4 + h];
        const float m = fmaxf(l0, fmaxf(l1, l2)); float w0 = __expf(l0 - m), w1 = __expf(l1 - m), w2 = __expf(l2 - m); const float inv = 1.0f / (w0 + w1 + w2); w0 *= inv; w1 *= inv; w2 *= inv;
        const u32x4 a = *(const u32x4*)(OA + (0 * (size_t)NTOK + tok) * 256 + c8), bq = *(const u32x4*)(OA + (1 * (size_t)NTOK + tok) * 256 + c8), c = *(const u32x4*)(OA + (2 * (size_t)NTOK + tok) * 256 + c8);
        const u32x4 gz = *(const u32x4*)(Z + tok * 8192 + C_GA + c8); u32x4 r;
#pragma unroll
        for (int j = 0; j < 4; ++j) { const float lo = (w0 * bflo(a[j]) + w1 * bflo(bq[j]) + w2 * bflo(c[j])) * siluf_(bflo(gz[j])), hi = (w0 * bfhi(a[j]) + w1 * bfhi(bq[j]) + w2 * bfhi(c[j])) * siluf_(bfhi(gz[j])); r[j] = pk2(lo, hi); }
        *(u32x4*)(UA + tok * 1024 + c8) = r; }
}
DI void phase_final(const Params& p) {
    const float* rss = (const float*)(p.ws + W_ROWSS); const u16* XN = (const u16*)(p.ws + W_MACC);
    const int tid = otid(); const size_t tot = (size_t)NTOK * 128, gs = (size_t)gridDim.x * 512;
    for (size_t q0 = (size_t)blockIdx.x * 512 + tid; q0 < tot; q0 += 4 * gs) { u32x4 v[4]; float4 g0[4], g1[4]; float rs[4];
#pragma unroll
        for (int j = 0; j < 4; ++j) { size_t q = q0 + j * gs; if (q >= tot) q = q0; const size_t row = q >> 7; const int c8 = (int)(q & 127) * 8;
            rs[j] = rss[row]; g0[j] = *(const float4*)(p.norm_final + c8); g1[j] = *(const float4*)(p.norm_final + c8 + 4); v[j] = *(const u32x4*)(XN + row * 1024 + c8); }
#pragma unroll
        for (int j = 0; j < 4; ++j) { const size_t q = q0 + j * gs; if (q < tot) { const size_t row = q >> 7; const int c8 = (int)(q & 127) * 8; const float r = rsqrtf(rs[j] * (1.0f / 1024.0f) + EPSN);
            float4 o0 = {bflo(v[j][0]) * r * g0[j].x, bfhi(v[j][0]) * r * g0[j].y, bflo(v[j][1]) * r * g0[j].z, bfhi(v[j][1]) * r * g0[j].w};
            float4 o1 = {bflo(v[j][2]) * r * g1[j].x, bfhi(v[j][2]) * r * g1[j].y, bflo(v[j][3]) * r * g1[j].z, bfhi(v[j][3]) * r * g1[j].w};
            *(float4*)(p.out + row * 1024 + c8) = o0; *(float4*)(p.out + row * 1024 + c8 + 4) = o1; } } }
}

#ifndef PHMASK
#define PHMASK 0xff
#endif
template <bool COOP>
__global__ __launch_bounds__(512, 2) void mega(Params p, int lo, int hi) {
    extern __shared__ __attribute__((aligned(16))) unsigned char shm[];
    char* smem = (char*)shm;
    PG8_LAS unsigned char* lds = (PG8_LAS unsigned char*)shm;
    const int G = (int)gridDim.x, c = (int)blockIdx.x;
#ifndef P2SUB
#define P2SUB 31
#endif
#ifndef XSYNC
#define XSYNC 0
#endif
#ifndef REP_MASK
#define REP_MASK 0
#endif
    XcdBarrier xb;
    if (COOP) {
        volatile PG8_LAS unsigned* st = (volatile PG8_LAS unsigned*)(lds + 131072);
        if (threadIdx.x == 0) { st[0] = 0u; st[1] = 0u; }
        __syncthreads();
        xb = xcd_barrier_post((unsigned*)(p.ws + W_BAR), st);
        if (lo < 0) cg::this_grid().sync();
        for (int i = 0; i < XSYNC; ++i) xcd_barrier(xb);
    }
    bool first = true;
    for (int pp = 2 * lo; pp < 2 * hi; ++pp) {
        const int ph = pp >> 1;
        if ((pp & 1) && !((REP_MASK >> ph) & 1)) continue;
        if (COOP && ph == 3) continue;
        if (COOP && ph == 7) continue;
        if (COOP && !first) xcd_barrier(xb);
        first = false;
        if (ph == 1 || ph == 5 || ph == 6) {
            GDesc d0, d1, d2, d3; MSched S; S.nsub = 1; S.has_extra = 0; S.ex_pm = 0; S.ex_pn = 0; S.ex_gi = 0;
            if (ph == 1) { d0 = GDesc{(const u16*)(p.ws + W_H), (const u16*)(p.ws + W_WINT), 1024, 0}; d1 = d0; d2 = d0; d3 = d0; S.so.init(NTOK_P, C_ZG, G, c); }
            else if (ph == 5) { const u16* H = (const u16*)(p.ws + W_H); const u16* WG = (const u16*)(p.ws + W_WINT) + (size_t)C_ZG * 1024;
                d0 = GDesc{H, WG, 1024, 7}; d1 = GDesc{H, WG + (size_t)1024 * 1024, 1024, 7}; d2 = GDesc{H, WG + (size_t)2048 * 1024, 1024, 7};
                d3 = GDesc{(const u16*)(p.ws + W_UA), (const u16*)(p.ws + W_WAT), 1024, 6}; S.so.init(NTOK_P, 1024, G, c); S.nsub = 4; }
            else { d0 = GDesc{(const u16*)(p.ws + W_MERGED), (const u16*)(p.ws + W_WOUTT), 1024, 5}; d1 = d0; d2 = d0; d3 = d0; S.so.init(NTOK_P, 1024, G, c); }
            S.nreg = c < S.so.nwg ? (S.so.nwg - c + G - 1) / G : 0;
            if (PHMASK & 2) { const size_t rsoff = (pp & 1) ? (W_SLOC - W_ROWSS) : 0; gemm_multi(lds, p, d0, d1, d2, d3, S, rsoff); phase_skinny(p, ph, rsoff); }
        }
        else if (ph == 0) { if (PHMASK & 1) phase_prep(p, smem); }
        else if (ph == 2) { if (PHMASK & 4) phase_mix(p, smem, (pp & 1) ? P2SUB : 31); }
        else if (ph == 3) { if (PHMASK & 8) phase_prefix(p); }
        else if (ph == 4) { if (PHMASK & 16) phase_hgout(p, smem); }
        else { if (PHMASK & 128) phase_final(p); }
    }
}

#ifndef MULTI_LAUNCH
#define MULTI_LAUNCH 0
#endif
extern "C" void kernel_launch(void* const* d_in, const int* in_sizes, int n_in, void* d_out, int out_size, void* d_ws, size_t ws_size, hipStream_t stream) {
    constexpr size_t kDynLds = 131072 + 16;
    static int grid_blocks = 0;
    if (!grid_blocks) {
        int dev = 0, cus = 0, per_cu = 0;
        hipGetDevice(&dev);
        hipDeviceGetAttribute(&cus, hipDeviceAttributeMultiprocessorCount, dev);
        hipFuncSetAttribute((const void*)mega<true>, hipFuncAttributeMaxDynamicSharedMemorySize, (int)kDynLds);
        hipFuncSetAttribute((const void*)mega<false>, hipFuncAttributeMaxDynamicSharedMemorySize, (int)kDynLds);
        hipOccupancyMaxActiveBlocksPerMultiprocessor(&per_cu, mega<true>, 512, kDynLds);
        if (per_cu < 1) per_cu = 1;
        if (per_cu > 1) per_cu = 1;
        grid_blocks = cus * per_cu;
        if (grid_blocks > 256) grid_blocks = 256;
    }
    Params p{};
    const float* const* in = (const float* const*)d_in;
    p.x_prompt = in[0]; p.x_sample = in[1]; p.mem_prompt = in[2]; p.c_w1 = in[3]; p.c_w2 = in[4]; p.c_w3 = in[5]; p.c_mem = in[6]; p.st_hgrn = in[7];
    p.norm_in = in[8]; p.w_in = in[9]; p.lb_logits = in[10]; p.norm_hgrn = in[11]; p.norm_mem = in[12]; p.w_mem_kv = in[13]; p.w_a = in[14]; p.w_b = in[15];
    p.w_m = in[16]; p.w_out = in[17]; p.norm_final = in[18];
    p.out = (float*)d_out; p.ws = (char*)d_ws;
#if MULTI_LAUNCH
    for (int ph = 0; ph < 8; ++ph) hipLaunchKernelGGL((mega<false>), dim3(grid_blocks), dim3(512), kDynLds, stream, p, ph, ph + 1);
#else
    int lo = 0, hi = 8;
    hipMemsetAsync((char*)d_ws + W_BAR, 0, BAR_ZERO_BYTES, stream);
    void* args[] = {&p, &lo, &hi};
    hipError_t e = hipLaunchCooperativeKernel((const void*)mega<true>, dim3(grid_blocks), dim3(512), args, kDynLds, stream);
    if (e != hipSuccess) fprintf(stderr, "cooperative launch failed: %s (grid %d)\n", hipGetErrorString(e), grid_blocks);
#endif
}
```
